# Optimizing an MI355X kernel written in HIP

```python
import jax, jax.numpy as jnp
from jax import lax
import numpy as np

D_MODEL = 1024
BATCH = 8
SEQ = 2048
DEPTH = 4

CHUNK = 128
A_WIDTH = D_MODEL
A_HEADS = 8
A_HEAD_DIM = A_WIDTH // A_HEADS
B_WIDTH = D_MODEL
B_GROUPS = 16
B_GROUP_DIM = B_WIDTH // B_GROUPS
CONV_WIDTH = 3
D_FF = ((8 * D_MODEL // 3 + 127) // 128) * 128
N_IN = 2 * A_WIDTH + 3 * B_WIDTH + 2 * D_MODEL
EPS = 1e-6

kernel_name = "macaron_gmlp_shortconv_gated_hybrid"


def rmsnorm(x, g):
    x32 = x.astype(jnp.float32)
    y = x32 * lax.rsqrt(jnp.mean(x32 * x32, axis=-1, keepdims=True) + EPS)
    return y.astype(x.dtype) * g


def swiglu(h, w_in, w_out):
    gate, up = jnp.split(h @ w_in, 2, axis=-1)
    return (jax.nn.silu(gate) * up) @ w_out


def spatial_gating(u, v, norm_g, w_s, b_s):
    bsz, s, _ = v.shape
    v = rmsnorm(v, norm_g)
    v = v.reshape(bsz, s // CHUNK, CHUNK, A_HEADS, A_HEAD_DIM)
    v = jnp.einsum('hqp,bcphd->bcqhd', w_s, v) + b_s.T[None, None, :, :, None]
    return u * v.reshape(bsz, s, A_WIDTH)


def short_conv(t, w):
    s = t.shape[1]
    pad = CONV_WIDTH // 2
    tp = jnp.pad(t, ((0, 0), (pad, CONV_WIDTH - 1 - pad), (0, 0)))
    out = w[0] * tp[:, 0:s]
    for k in range(1, CONV_WIDTH):
        out = out + w[k] * tp[:, k:k + s]
    return out


def hybrid_mixer(h, w_in, sgu_norm, sgu_w, sgu_b, conv_w, w_proj_a, w_proj_b, w_out):
    z = h @ w_in
    za, zb, zg = jnp.split(z, [2 * A_WIDTH, 2 * A_WIDTH + 3 * B_WIDTH], axis=-1)
    u, v = jnp.split(jax.nn.gelu(za), 2, axis=-1)
    y_a = spatial_gating(u, v, sgu_norm, sgu_w, sgu_b) @ w_proj_a
    gate_b, gate_c, xb = jnp.split(zb, 3, axis=-1)
    y_b = (gate_b * short_conv(gate_c * xb, conv_w)) @ w_proj_b
    g_a, g_b = jnp.split(zg, 2, axis=-1)
    merged = jax.nn.sigmoid(g_a) * y_a + jax.nn.sigmoid(g_b) * y_b
    return merged @ w_out


def setup_inputs(seed: int = 0) -> dict:
    key = jax.random.key(seed)
    ks = jax.random.split(key, 20)
    f32 = jnp.float32

    def nrm(k, shape, scale):
        return jax.random.normal(k, shape, f32) * scale

    def gain(k, shape):
        return 1.0 + 0.05 * jax.random.normal(k, shape, f32)

    return {
        "x": nrm(ks[0], (BATCH, SEQ, D_MODEL), 1.0),
        "ffn1_norm": gain(ks[1], (DEPTH, D_MODEL)),
        "ffn1_w_in": nrm(ks[2], (DEPTH, D_MODEL, 2 * D_FF), D_MODEL ** -0.5),
        "ffn1_w_out": nrm(ks[3], (DEPTH, D_FF, D_MODEL), D_FF ** -0.5),
        "mix_norm": gain(ks[4], (DEPTH, D_MODEL)),
        "w_in": nrm(ks[5], (DEPTH, D_MODEL, N_IN), D_MODEL ** -0.5),
        "sgu_norm": gain(ks[6], (DEPTH, A_WIDTH)),
        "sgu_w": nrm(ks[7], (DEPTH, A_HEADS, CHUNK, CHUNK), CHUNK ** -0.5),
        "sgu_b": gain(ks[8], (DEPTH, A_HEADS, CHUNK)),
        "conv_w": nrm(ks[9], (DEPTH, CONV_WIDTH, B_WIDTH), CONV_WIDTH ** -0.5),
        "w_proj_a": nrm(ks[10], (DEPTH, A_WIDTH, D_MODEL), A_WIDTH ** -0.5),
        "w_proj_b": nrm(ks[11], (DEPTH, B_WIDTH, D_MODEL), B_WIDTH ** -0.5),
        "w_out": nrm(ks[12], (DEPTH, D_MODEL, D_MODEL), D_MODEL ** -0.5),
        "ffn2_norm": gain(ks[13], (DEPTH, D_MODEL)),
        "ffn2_w_in": nrm(ks[14], (DEPTH, D_MODEL, 2 * D_FF), D_MODEL ** -0.5),
        "ffn2_w_out": nrm(ks[15], (DEPTH, D_FF, D_MODEL), D_FF ** -0.5),
        "final_norm": gain(ks[16], (D_MODEL,)),
    }


def reference(x, ffn1_norm, ffn1_w_in, ffn1_w_out, mix_norm, w_in, sgu_norm, sgu_w,
              sgu_b, conv_w, w_proj_a, w_proj_b, w_out, ffn2_norm, ffn2_w_in,
              ffn2_w_out, final_norm):
    for l in range(DEPTH):
        x = x + 0.5 * swiglu(rmsnorm(x, ffn1_norm[l]), ffn1_w_in[l], ffn1_w_out[l])
        x = x + hybrid_mixer(rmsnorm(x, mix_norm[l]), w_in[l], sgu_norm[l], sgu_w[l],
                             sgu_b[l], conv_w[l], w_proj_a[l], w_proj_b[l], w_out[l])
        x = x + 0.5 * swiglu(rmsnorm(x, ffn2_norm[l]), ffn2_w_in[l], ffn2_w_out[l])
    return rmsnorm(x, final_norm)
```

```cpp
#include <hip/hip_runtime.h>
#include <hip/hip_cooperative_groups.h>
#include <cstdio>
#include <cstdint>
namespace cg = cooperative_groups;

#ifndef MK_SINGLE
#define MK_SINGLE 0
#endif
#ifndef MK_XCDBAR
#define MK_XCDBAR 0
#endif

constexpr int BATCH = 8, SEQ = 2048, D = 1024, DEPTH = 4, FF = 2816, NIN = 7168, CHUNK = 128, HEADS = 8;
constexpr int M = BATCH * SEQ;
constexpr float EPS = 1e-6f;

namespace pg8 {
#define PG8_LAS __attribute__((address_space(3)))
typedef unsigned short bf16_t;
typedef short bf16x8 __attribute__((ext_vector_type(8)));
typedef float f32x4 __attribute__((ext_vector_type(4)));
typedef unsigned u32x4 __attribute__((ext_vector_type(4)));
constexpr int BM = 256, BK = 64, HALF = 128, HTB = HALF * BK * 2  , STAGE_BYTES = 8 * HTB, NXCD = 8, WGM = 8;

__host__ __device__ __forceinline__ int lds_byte(int r, int c) { const int st = (r >> 4) * 2 + (c >> 5), rr = r & 15, cc = c & 31, ob = rr * 64 + cc * 2; return st * 1024 + (ob ^ (((ob >> 9) & 1) << 5)); }
__host__ __device__ __forceinline__ void stage_rc(int b, int& R, int& C) { const int st = b / 1024, sb = b % 1024, swz = sb ^ (((sb >> 9) & 1) << 5); R = (st >> 1) * 16 + swz / 64; C = (st & 1) * 32 + (swz % 64) / 2; }
__host__ __device__ __forceinline__ int perm32(int rho) { const int n = rho >> 4, i = rho & 15; return 8 * (i >> 2) + 4 * n + (i & 3); }

struct Unit { int pm, pn; };
struct Gemm { const bf16_t* A; const bf16_t* Bt; int M, N, K; };

struct StaticOrder {
    int nM, nN, nwg, G, c;
    __host__ __device__ void init(int M, int N, int G_, int c_) { nM = M / BM; nN = N / BM; nwg = nM * nN; G = G_; c = c_; }
    __host__ __device__ bool next(int i, Unit& u) const {
        const long L = (long)i * G + c; if (L >= nwg) return false;
        int wgid = (int)L; { const int q = nwg / NXCD, r = nwg % NXCD, xcd = wgid % NXCD, off = wgid / NXCD; wgid = (xcd < r ? xcd * (q + 1) : r * (q + 1) + (xcd - r) * q) + off; }
        const int nig = WGM * nN, gid = wgid / nig, fm = gid * WGM, gsz = (nM - fm) < WGM ? (nM - fm) : WGM;
        u.pm = fm + ((wgid % nig) % gsz); u.pn = (wgid % nig) / gsz; return true;
    }
    __device__ __forceinline__ void a_ready(const Unit&) const {}
    __device__ __forceinline__ void done(const Unit&) const {}
};
__device__ __forceinline__ unsigned cvt_pk_bf16(float lo, float hi) { unsigned r; asm volatile("v_cvt_pk_bf16_f32 %0, %1, %2" : "=v"(r) : "v"(lo), "v"(hi)); return r; }
typedef unsigned u32x2 __attribute__((ext_vector_type(2)));
__device__ __forceinline__ float fsigmoid(float x) { return __builtin_amdgcn_rcpf(1.0f + __builtin_amdgcn_exp2f(-1.44269504089f * x)); }
__device__ __forceinline__ float fsilu(float x) { return x * fsigmoid(x); }
__device__ __forceinline__ float fgelu(float x) { return x * fsigmoid(1.59576912161f * (x + 0.044715f * x * x * x)); }
__device__ __forceinline__ float bflo(unsigned w) { return __uint_as_float(w << 16); }
__device__ __forceinline__ float bfhi(unsigned w) { return __uint_as_float(w & 0xffff0000u); }
__device__ __forceinline__ u32x4 pack8(const f32x4 a, const f32x4 b) { u32x4 w; w.x = cvt_pk_bf16(a[0], a[1]); w.y = cvt_pk_bf16(a[2], a[3]); w.z = cvt_pk_bf16(b[0], b[1]); w.w = cvt_pk_bf16(b[2], b[3]); return w; }
__device__ __forceinline__ void unpack8(const u32x4 w, f32x4& a, f32x4& b) { a = (f32x4){bflo(w.x), bfhi(w.x), bflo(w.y), bfhi(w.y)}; b = (f32x4){bflo(w.z), bfhi(w.z), bflo(w.w), bfhi(w.w)}; }
__device__ __forceinline__ float sum4(const f32x4 v) { return (v[0] + v[1]) + (v[2] + v[3]); }
__device__ __forceinline__ float dot4(const f32x4 v) { return (v[0] * v[0] + v[1] * v[1]) + (v[2] * v[2] + v[3] * v[3]); }
__device__ __forceinline__ float row_rstd(const float* PS, int row, int fq) {
    float s = sum4(*(const f32x4*)(PS + (size_t)row * 16 + 4 * fq)); s += __shfl_xor(s, 16); s += __shfl_xor(s, 32);
    return rsqrtf(s * (1.0f / 1024.0f) + EPS);
}

struct EpiFfnUp {
    static constexpr bool PERM = true, AFTER_DRAIN = false;
    bf16_t* H; const float* PS;
    __device__ __forceinline__ void operator()(const f32x4 (&acc)[2][2][4][2], const Unit& u, int wr, int wc, int fr, int fq) const {
        const int row0 = u.pm * BM + wr * 64 + fr, col0 = u.pn * 128 + wc * 32 + 8 * fq;
#pragma unroll
        for (int ai = 0; ai < 2; ++ai)
#pragma unroll
            for (int m = 0; m < 4; ++m) { const int row = row0 + ai * HALF + m * 16; const float rs = row_rstd(PS, row, fq);
                f32x4 h0, h1;
#pragma unroll
                for (int j = 0; j < 4; ++j) { h0[j] = fsilu(acc[ai][0][m][0][j] * rs) * (acc[ai][1][m][0][j] * rs); h1[j] = fsilu(acc[ai][0][m][1][j] * rs) * (acc[ai][1][m][1][j] * rs); }
                *(u32x4*)(H + (size_t)row * FF + col0) = pack8(h0, h1); }
    }
};
struct EpiResid {
    static constexpr bool PERM = true, AFTER_DRAIN = false;
    const float* xs; float* xd; bf16_t* XB; float* PS; float scale;
    __device__ __forceinline__ void operator()(const f32x4 (&acc)[2][2][4][2], const Unit& u, int wr, int wc, int fr, int fq) const {
        const int row0 = u.pm * BM + wr * 64 + fr, col0 = u.pn * BM + wc * 32 + 8 * fq;
#pragma unroll
        for (int ai = 0; ai < 2; ++ai)
#pragma unroll
            for (int m = 0; m < 4; ++m) { const int row = row0 + ai * HALF + m * 16; float ss = 0.f;
#pragma unroll
                for (int bj = 0; bj < 2; ++bj) { const size_t off = (size_t)row * D + col0 + bj * HALF;
                    f32x4 a = *(const f32x4*)(xs + off), b = *(const f32x4*)(xs + off + 4);
                    a = a + acc[ai][bj][m][0] * scale; b = b + acc[ai][bj][m][1] * scale;
                    *(f32x4*)(xd + off) = a; *(f32x4*)(xd + off + 4) = b; ss += dot4(a) + dot4(b);
                    *(u32x4*)(XB + off) = pack8(a, b); }
                ss += __shfl_xor(ss, 16); ss += __shfl_xor(ss, 32);
                if (fq == 0) PS[(size_t)row * 16 + u.pn * 4 + wc] = ss;
                asm volatile("" ::: "memory"); }
    }
};
struct EpiMixIn {
    static constexpr bool PERM = true, AFTER_DRAIN = false;
    bf16_t *U, *V, *T, *GB, *SA, *SB; const float* PS; float* PSV;
    __device__ __forceinline__ void operator()(const f32x4 (&acc)[2][2][4][2], const Unit& u, int wr, int wc, int fr, int fq) const {
        const int pn = u.pn, row0 = u.pm * BM + wr * 64 + fr, cw = wc * 32 + 8 * fq;
        if (pn >= 12 && pn < 20) {
            const int col = (pn - 12) * 128 + cw;
#pragma unroll
            for (int ai = 0; ai < 2; ++ai)
#pragma unroll
                for (int m = 0; m < 4; ++m) { const int row = row0 + ai * HALF + m * 16; const float rs = row_rstd(PS, row, fq), r2 = rs * rs;
                    const f32x4 t0 = acc[ai][0][m][0] * acc[ai][1][m][0] * r2, t1 = acc[ai][0][m][1] * acc[ai][1][m][1] * r2;
                    *(u32x4*)(T + (size_t)row * D + col) = pack8(t0, t1); }
        } else {
            bf16_t* O; int cb, act;
            if (pn < 4) { O = U; cb = pn * 256; act = 1; } else if (pn < 8) { O = V; cb = (pn - 4) * 256; act = 2; } else if (pn < 12) { O = GB; cb = (pn - 8) * 256; act = 0; }
            else if (pn < 24) { O = SA; cb = (pn - 20) * 256; act = 3; } else { O = SB; cb = (pn - 24) * 256; act = 3; }
#pragma unroll
            for (int ai = 0; ai < 2; ++ai)
#pragma unroll
                for (int m = 0; m < 4; ++m) { const int row = row0 + ai * HALF + m * 16; const float rs = row_rstd(PS, row, fq); float ss = 0.f;
#pragma unroll
                    for (int bj = 0; bj < 2; ++bj) { f32x4 v0 = acc[ai][bj][m][0] * rs, v1 = acc[ai][bj][m][1] * rs;
                        if (act == 1 || act == 2) {
#pragma unroll
                            for (int j = 0; j < 4; ++j) { v0[j] = fgelu(v0[j]); v1[j] = fgelu(v1[j]); }
                            ss += dot4(v0) + dot4(v1);
                        } else if (act == 3) {
#pragma unroll
                            for (int j = 0; j < 4; ++j) { v0[j] = fsigmoid(v0[j]); v1[j] = fsigmoid(v1[j]); }
                        }
                        *(u32x4*)(O + (size_t)row * D + cb + bj * HALF + cw) = pack8(v0, v1); }
                    if (act == 2) { ss += __shfl_xor(ss, 16); ss += __shfl_xor(ss, 32); if (fq == 0) PSV[(size_t)row * 16 + (pn - 4) * 4 + wc] = ss; } }
        }
    }
};
struct EpiProjA {
    static constexpr bool PERM = true, AFTER_DRAIN = false;
    const bf16_t* SA; float* ST;
    __device__ __forceinline__ void operator()(const f32x4 (&acc)[2][2][4][2], const Unit& u, int wr, int wc, int fr, int fq) const {
        const int row0 = u.pm * BM + wr * 64 + fr, col0 = u.pn * BM + wc * 32 + 8 * fq;
#pragma unroll
        for (int ai = 0; ai < 2; ++ai)
#pragma unroll
            for (int m = 0; m < 4; ++m) { const int row = row0 + ai * HALF + m * 16;
#pragma unroll
                for (int bj = 0; bj < 2; ++bj) { const size_t off = (size_t)row * D + col0 + bj * HALF;
                    f32x4 g0, g1; unpack8(*(const u32x4*)(SA + off), g0, g1);
                    *(f32x4*)(ST + off) = g0 * acc[ai][bj][m][0]; *(f32x4*)(ST + off + 4) = g1 * acc[ai][bj][m][1]; }
                asm volatile("" ::: "memory"); }
    }
};
struct EpiProjB {
    static constexpr bool PERM = true, AFTER_DRAIN = false;
    const bf16_t* SB; const float* ST; bf16_t* MG;
    __device__ __forceinline__ void operator()(const f32x4 (&acc)[2][2][4][2], const Unit& u, int wr, int wc, int fr, int fq) const {
        const int row0 = u.pm * BM + wr * 64 + fr, col0 = u.pn * BM + wc * 32 + 8 * fq;
#pragma unroll
        for (int ai = 0; ai < 2; ++ai)
#pragma unroll
            for (int m = 0; m < 4; ++m) { const int row = row0 + ai * HALF + m * 16;
#pragma unroll
                for (int bj = 0; bj < 2; ++bj) { const size_t off = (size_t)row * D + col0 + bj * HALF;
                    f32x4 g0, g1; unpack8(*(const u32x4*)(SB + off), g0, g1);
                    const f32x4 p0 = *(const f32x4*)(ST + off), p1 = *(const f32x4*)(ST + off + 4);
                    *(u32x4*)(MG + off) = pack8(p0 + g0 * acc[ai][bj][m][0], p1 + g1 * acc[ai][bj][m][1]); }
                asm volatile("" ::: "memory"); }
    }
};

template <class Epi, class Sched, bool ALIGN_EPI = false, bool SP2 = false>
__device__ __forceinline__ void gemm_phase(PG8_LAS unsigned char* lds, const Gemm g, const Sched& S, const Epi& E) {
    int tid_ = threadIdx.x; asm volatile("" : "+v"(tid_));
    const int tid = tid_, wid = __builtin_amdgcn_readfirstlane(tid >> 6), lane = tid & 63, wr = wid >> 2, wc = wid & 3, fr = lane & 15, fq = lane >> 4;
    const int K = g.K, nt = K / BK;
    unsigned voffA[2], voffB[2];
#pragma unroll
    for (int i = 0; i < 2; ++i) { int R, C; stage_rc(tid * 16 + i * 8192, R, C); const int Rb = Epi::PERM ? ((R & ~31) + perm32(R & 31)) : R;
        voffA[i] = (unsigned)(R * K + C) * 2u; voffB[i] = (unsigned)(Rb * K + C) * 2u; }
    const size_t kstep = (size_t)(BK * 2);
    const size_t hstep = (size_t)HALF * K * 2;
    const size_t tstep = 2 * hstep;
    const unsigned ldsw = (unsigned)wid * 1024u;
    const int aoff = lds_byte(wr * 64 + fr, fq * 8), boff = lds_byte(wc * 32 + fr, fq * 8);
#define PG8_SA(b, h) (((b) * 2 + (h)) * HTB)
#define PG8_SB(b, h) ((4 + (b) * 2 + (h)) * HTB)
#define PG8_STAGE(bufoff, gbase, voff) do { _Pragma("unroll") for (int _i = 0; _i < 2; ++_i) \
        __builtin_amdgcn_global_load_lds((const unsigned*)((const char*)(gbase) + (voff)[_i]), (PG8_LAS unsigned*)(lds + (bufoff) + ldsw + _i * 8192), 16, 0, 0); } while (0)
#define PG8_LDA(dst, b, h) do { _Pragma("unroll") for (int m = 0; m < 4; ++m) _Pragma("unroll") for (int k = 0; k < 2; ++k) dst[m][k] = *(const PG8_LAS bf16x8*)(lds + PG8_SA(b, h) + aoff + m * 2048 + k * 1024); } while (0)
#define PG8_LDB(dst, b, h) do { _Pragma("unroll") for (int n = 0; n < 2; ++n) _Pragma("unroll") for (int k = 0; k < 2; ++k) dst[n][k] = *(const PG8_LAS bf16x8*)(lds + PG8_SB(b, h) + boff + n * 2048 + k * 1024); } while (0)
#define PG8_MMA(ai, bj, At, Bt) do { __builtin_amdgcn_s_setprio(1); _Pragma("unroll") for (int m = 0; m < 4; ++m) _Pragma("unroll") for (int n = 0; n < 2; ++n) _Pragma("unroll") for (int k = 0; k < 2; ++k) \
        acc[ai][bj][m][n] = __builtin_amdgcn_mfma_f32_16x16x32_bf16(Bt[n][k], At[m][k], acc[ai][bj][m][n], 0, 0, 0); __builtin_amdgcn_s_setprio(0); } while (0)
#define PG8_WAIT_V(n) asm volatile("s_waitcnt vmcnt(" #n ")" ::: "memory")
#define PG8_WAIT_L(n) asm volatile("s_waitcnt lgkmcnt(" #n ")" ::: "memory")
#define PG8_BAR __builtin_amdgcn_s_barrier()
#define PG8_SCHED __builtin_amdgcn_sched_barrier(0)
    Unit cur, nxt; int ui = 0;
    if (!S.next(0, cur)) return;
    f32x4 acc[2][2][4][2];
#pragma unroll
    for (int a = 0; a < 2; ++a)
#pragma unroll
        for (int b = 0; b < 2; ++b)
#pragma unroll
            for (int m = 0; m < 4; ++m)
#pragma unroll
                for (int n = 0; n < 2; ++n) acc[a][b][m][n] = (f32x4){0.f, 0.f, 0.f, 0.f};
    bf16x8 At[4][2], B0[2][2], B1[2][2];
    const char* cA = (const char*)g.A + (size_t)cur.pm * tstep; const char* cB = (const char*)g.Bt + (size_t)cur.pn * tstep;
    S.a_ready(cur);
    if constexpr (SP2) {
        PG8_STAGE(PG8_SB(0, 0), cB, voffB); PG8_STAGE(PG8_SB(0, 1), cB + hstep, voffB); PG8_STAGE(PG8_SA(0, 0), cA, voffA); PG8_STAGE(PG8_SA(0, 1), cA + hstep, voffA);
        if (wr == 1) PG8_BAR;
        PG8_WAIT_V(2); PG8_BAR;
        PG8_STAGE(PG8_SB(1, 0), cB + kstep, voffB); PG8_STAGE(PG8_SA(1, 0), cA + kstep, voffA); PG8_STAGE(PG8_SB(1, 1), cB + hstep + kstep, voffB);
        PG8_WAIT_V(6); PG8_BAR;
    } else {
        PG8_STAGE(PG8_SB(0, 0), cB, voffB); PG8_STAGE(PG8_SA(0, 0), cA, voffA); PG8_STAGE(PG8_SB(0, 1), cB + hstep, voffB); PG8_STAGE(PG8_SA(0, 1), cA + hstep, voffA);
        if (wr == 1) PG8_BAR;
        PG8_WAIT_V(4); PG8_BAR;
        PG8_STAGE(PG8_SB(1, 0), cB + kstep, voffB); PG8_STAGE(PG8_SA(1, 0), cA + kstep, voffA); PG8_STAGE(PG8_SB(1, 1), cB + hstep + kstep, voffB);
        PG8_WAIT_V(6); PG8_BAR;
    }
    for (;;) {
        const bool has_next = S.next(ui + 1, nxt);
        const char* nA = has_next ? (const char*)g.A + (size_t)nxt.pm * tstep : cA; const char* nB = has_next ? (const char*)g.Bt + (size_t)nxt.pn * tstep : cB;
        for (int t = 0; t < nt; t += 2) {
            const bool last = (t == nt - 2);
            const char* a1 = cA + (size_t)(t + 1) * kstep;
            const char* a2 = last ? nA : cA + (size_t)(t + 2) * kstep; const char* b2 = last ? nB : cB + (size_t)(t + 2) * kstep;
            const char* a3 = a2 + kstep; const char* b3 = b2 + kstep;
            if (last && has_next) S.a_ready(nxt);
            if constexpr (SP2) {
            PG8_LDB(B0, 0, 0); PG8_LDB(B1, 0, 1); PG8_SCHED; PG8_LDA(At, 0, 0); PG8_STAGE(PG8_SA(1, 1), a1 + hstep, voffA);
            PG8_WAIT_V(8); PG8_WAIT_L(0); PG8_BAR; PG8_MMA(0, 0, At, B0); PG8_MMA(0, 1, At, B1); PG8_BAR; PG8_SCHED;
            PG8_LDA(At, 0, 1); PG8_STAGE(PG8_SB(0, 0), b2, voffB); PG8_STAGE(PG8_SB(0, 1), b2 + hstep, voffB); PG8_STAGE(PG8_SA(0, 0), a2, voffA);
            PG8_WAIT_V(8); PG8_WAIT_L(0); PG8_BAR; PG8_MMA(1, 0, At, B0); PG8_MMA(1, 1, At, B1); PG8_BAR; PG8_SCHED;
            PG8_LDB(B0, 1, 0); PG8_LDB(B1, 1, 1); PG8_SCHED; PG8_LDA(At, 1, 0); PG8_STAGE(PG8_SA(0, 1), a2 + hstep, voffA);
            PG8_WAIT_V(8); PG8_WAIT_L(0); PG8_BAR; PG8_MMA(0, 0, At, B0); PG8_MMA(0, 1, At, B1); PG8_BAR; PG8_SCHED;
            PG8_LDA(At, 1, 1); PG8_STAGE(PG8_SB(1, 0), b3, voffB); PG8_STAGE(PG8_SB(1, 1), b3 + hstep, voffB); PG8_STAGE(PG8_SA(1, 0), a3, voffA);
            PG8_WAIT_V(8); PG8_WAIT_L(0); PG8_BAR; PG8_MMA(1, 0, At, B0); PG8_MMA(1, 1, At, B1); PG8_BAR; PG8_SCHED;
            } else {
            PG8_LDB(B0, 0, 0); PG8_SCHED; PG8_LDA(At, 0, 0); PG8_STAGE(PG8_SA(1, 1), a1 + hstep, voffA);
            PG8_WAIT_L(8); PG8_BAR; PG8_WAIT_L(0); PG8_MMA(0, 0, At, B0); PG8_BAR; PG8_SCHED;
            PG8_LDB(B1, 0, 1); PG8_STAGE(PG8_SB(0, 0), b2, voffB);
            PG8_BAR; PG8_WAIT_L(0); PG8_MMA(0, 1, At, B1); PG8_BAR;
            PG8_LDA(At, 0, 1); PG8_STAGE(PG8_SA(0, 0), a2, voffA);
            PG8_BAR; PG8_WAIT_L(0); PG8_MMA(1, 0, At, B0); PG8_BAR; PG8_SCHED;
            PG8_STAGE(PG8_SB(0, 1), b2 + hstep, voffB);
            PG8_WAIT_V(6); PG8_BAR; PG8_MMA(1, 1, At, B1); PG8_BAR;
            PG8_LDB(B0, 1, 0); PG8_SCHED; PG8_LDA(At, 1, 0); PG8_STAGE(PG8_SA(0, 1), a2 + hstep, voffA);
            PG8_WAIT_L(8); PG8_BAR; PG8_WAIT_L(0); PG8_MMA(0, 0, At, B0); PG8_BAR; PG8_SCHED;
            PG8_LDB(B1, 1, 1); PG8_STAGE(PG8_SB(1, 0), b3, voffB);
            PG8_BAR; PG8_WAIT_L(0); PG8_MMA(0, 1, At, B1); PG8_BAR;
            PG8_LDA(At, 1, 1); PG8_STAGE(PG8_SA(1, 0), a3, voffA);
            PG8_BAR; PG8_WAIT_L(0); PG8_MMA(1, 0, At, B0); PG8_BAR; PG8_SCHED;
            PG8_STAGE(PG8_SB(1, 1), b3 + hstep, voffB);
            PG8_WAIT_V(6); PG8_BAR; PG8_MMA(1, 1, At, B1); PG8_BAR;
            }
        }
        if constexpr (ALIGN_EPI) { if (wr == 0) PG8_BAR; }
        if constexpr (!Epi::AFTER_DRAIN) { E(acc, cur, wr, wc, fr, fq); S.done(cur); }
        if (!has_next) break;
#pragma unroll
        for (int a = 0; a < 2; ++a)
#pragma unroll
            for (int b = 0; b < 2; ++b)
#pragma unroll
                for (int m = 0; m < 4; ++m)
#pragma unroll
                    for (int n = 0; n < 2; ++n) acc[a][b][m][n] = (f32x4){0.f, 0.f, 0.f, 0.f};
        cur = nxt; cA = nA; cB = nB; ++ui;
        if constexpr (ALIGN_EPI) { if (wr == 1) PG8_BAR; }
    }
    PG8_WAIT_V(0);
    if constexpr (!ALIGN_EPI) { if (wr == 0) PG8_BAR; }
    PG8_BAR;
    if constexpr (Epi::AFTER_DRAIN) { E.fused(acc, cur, wr, wc, fr, fq, lds, wid, lane); S.done(cur); }
#undef PG8_SA
#undef PG8_SB
#undef PG8_STAGE
#undef PG8_LDA
#undef PG8_LDB
#undef PG8_MMA
#undef PG8_WAIT_V
#undef PG8_WAIT_L
#undef PG8_BAR
#undef PG8_SCHED
}
}

#define LAS __attribute__((address_space(3)))
typedef unsigned short bf16;
typedef float f32x4 __attribute__((ext_vector_type(4)));
typedef unsigned u32x4 __attribute__((ext_vector_type(4)));
typedef unsigned u32x2 __attribute__((ext_vector_type(2)));
typedef short bf16x8 __attribute__((ext_vector_type(8)));
constexpr int NWAVES = 8, NTHREADS = 512;
constexpr int LDS_BYTES = 147456;
constexpr int MISC_OFF = 131072;
constexpr size_t MiB = 1u << 20;
constexpr size_t WS_CTL = 0, CTL_BYTES = 1 * MiB;
constexpr size_t WS_PS = 1 * MiB, WS_PSV = 2 * MiB;
constexpr size_t WS_XB = 4 * MiB;
constexpr size_t WS_ACT = 36 * MiB;
constexpr size_t A_H = 0;
constexpr size_t A_U = 0, A_V = 32 * MiB, A_T = 64 * MiB, A_GB = 96 * MiB, A_SA = 128 * MiB, A_SB = 160 * MiB;
constexpr size_t WS_W = 228 * MiB;
constexpr size_t E_FIN = (size_t)2 * FF * D, E_FOUT = (size_t)D * FF, E_WIN = (size_t)NIN * D, E_SQ = (size_t)D * D;
constexpr size_t O_F1I = 0, O_F1O = O_F1I + E_FIN, O_WIN = O_F1O + E_FOUT, O_PA = O_WIN + E_WIN, O_PB = O_PA + E_SQ, O_WO = O_PB + E_SQ, O_F2I = O_WO + E_SQ, O_F2O = O_F2I + E_FIN, E_LAYER = O_F2O + E_FOUT;
constexpr size_t WS_END = WS_W + (size_t)DEPTH * E_LAYER * 2;
static_assert(E_LAYER * 2 == 53 * MiB, "layer weight bytes");
static_assert((size_t)M * FF * 2 <= 192 * MiB, "H fits");

__device__ __forceinline__ float wave_sum(float v) {
#pragma unroll
    for (int o = 1; o < 64; o <<= 1) v += __shfl_xor(v, o);
    return v;
}
#define LDS_WAIT() asm volatile("s_waitcnt lgkmcnt(0)" ::: "memory")

__device__ __forceinline__ int colmap(int mode, int n) {
    if (mode == 1) { const int pn = n >> 8, half = (n >> 7) & 1, jj = n & 127; return half * FF + pn * 128 + jj; }
    if (mode == 2) { if (n < 3072 || n >= 5120) return n; const int r = n - 3072, q = r >> 8, half = (r >> 7) & 1, jj = r & 127; return 3072 + half * 1024 + q * 128 + jj; }
    return n;
}
__device__ __forceinline__ void transpose_item(const float* W, int K, int Nsrc, int Ndst, int mode, const float* scale, bf16* WT, LAS float* scr, int item, int lane) {
    const int nblk = Ndst / 32, kb = item / nblk, nb = item % nblk, k0 = 64 * kb, n0 = 32 * nb, s0 = colmap(mode, n0);
#pragma unroll 8
    for (int i = 0; i < 32; ++i) { const int kk = 2 * i + (lane >> 5); float v = W[(size_t)(k0 + kk) * Nsrc + s0 + (lane & 31)]; if (scale) v *= scale[k0 + kk]; scr[kk * 33 + (lane & 31)] = v; }
    LDS_WAIT(); asm volatile("" ::: "memory");
    const int c = lane & 7;
#pragma unroll
    for (int j = 0; j < 4; ++j) { const int n = (lane >> 3) + 8 * j; const LAS float* s = scr + (8 * c) * 33 + n;
        u32x4 o; o.x = pg8::cvt_pk_bf16(s[0 * 33], s[1 * 33]); o.y = pg8::cvt_pk_bf16(s[2 * 33], s[3 * 33]); o.z = pg8::cvt_pk_bf16(s[4 * 33], s[5 * 33]); o.w = pg8::cvt_pk_bf16(s[6 * 33], s[7 * 33]);
        *(u32x4*)(WT + (size_t)(n0 + n) * K + k0 + 8 * c) = o; }
    LDS_WAIT(); asm volatile("" ::: "memory");
}

struct Args { const float* in[17]; float* out; unsigned char* ws; int ph_lo, ph_hi; };
enum { I_X = 0, I_F1N, I_F1I, I_F1O, I_MN, I_WIN, I_SGN, I_SGW, I_SGB, I_CW, I_PA, I_PB, I_WO, I_F2N, I_F2I, I_F2O, I_FN };

__device__ __forceinline__ void prologue(const __attribute__((address_space(4))) Args* ap, LAS unsigned char* lds, int gw, int NGW, int wave, int lane) {
    LAS float* scr = (LAS float*)(lds + wave * 16384);
    bf16* WB = (bf16*)(ap->ws + WS_W);
    constexpr int IT_FIN = (D / 64) * (2 * FF / 32), IT_FOUT = (FF / 64) * (D / 32), IT_WIN = (D / 64) * (NIN / 32), IT_SQ = (D / 64) * (D / 32);
    constexpr int IT_LAYER = 2 * IT_FIN + 2 * IT_FOUT + IT_WIN + 3 * IT_SQ, IT_ALL = DEPTH * IT_LAYER;
    for (int g = gw; g < IT_ALL; g += NGW) {
        const int l = g / IT_LAYER; int r = g % IT_LAYER; bf16* wl = WB + (size_t)l * E_LAYER;
        if (r < IT_FIN) { transpose_item(ap->in[I_F1I] + (size_t)l * D * 2 * FF, D, 2 * FF, 2 * FF, 1, ap->in[I_F1N] + l * D, wl + O_F1I, scr, r, lane); continue; } r -= IT_FIN;
        if (r < IT_FOUT) { transpose_item(ap->in[I_F1O] + (size_t)l * FF * D, FF, D, D, 0, nullptr, wl + O_F1O, scr, r, lane); continue; } r -= IT_FOUT;
        if (r < IT_WIN) { transpose_item(ap->in[I_WIN] + (size_t)l * D * NIN, D, NIN, NIN, 2, ap->in[I_MN] + l * D, wl + O_WIN, scr, r, lane); continue; } r -= IT_WIN;
        if (r < IT_SQ) { transpose_item(ap->in[I_PA] + (size_t)l * D * D, D, D, D, 0, nullptr, wl + O_PA, scr, r, lane); continue; } r -= IT_SQ;
        if (r < IT_SQ) { transpose_item(ap->in[I_PB] + (size_t)l * D * D, D, D, D, 0, nullptr, wl + O_PB, scr, r, lane); continue; } r -= IT_SQ;
        if (r < IT_SQ) { transpose_item(ap->in[I_WO] + (size_t)l * D * D, D, D, D, 0, nullptr, wl + O_WO, scr, r, lane); continue; } r -= IT_SQ;
        if (r < IT_FIN) { transpose_item(ap->in[I_F2I] + (size_t)l * D * 2 * FF, D, 2 * FF, 2 * FF, 1, ap->in[I_F2N] + l * D, wl + O_F2I, scr, r, lane); continue; } r -= IT_FIN;
        transpose_item(ap->in[I_F2O] + (size_t)l * FF * D, FF, D, D, 0, nullptr, wl + O_F2O, scr, r, lane);
    }
    const float* x = ap->in[I_X]; bf16* XB = (bf16*)(ap->ws + WS_XB); float* PS = (float*)(ap->ws + WS_PS);
    for (int m = gw; m < M; m += NGW) {
        const f32x4* xr = (const f32x4*)(x + (size_t)m * D) + lane; f32x4 v[4]; float s = 0.f;
#pragma unroll
        for (int j = 0; j < 4; ++j) { v[j] = xr[64 * j]; s += pg8::dot4(v[j]); }
        s = wave_sum(s);
        u32x2* o8 = (u32x2*)(XB + (size_t)m * D) + lane;
#pragma unroll
        for (int j = 0; j < 4; ++j) { u32x2 w; w.x = pg8::cvt_pk_bf16(v[j][0], v[j][1]); w.y = pg8::cvt_pk_bf16(v[j][2], v[j][3]); o8[64 * j] = w; }
        if (lane < 16) PS[(size_t)m * 16 + lane] = lane == 0 ? s : 0.f;
    }
}

__device__ __forceinline__ void sgu_tile(LAS unsigned char* lds, int c, int h, bf16* U, const bf16* V, const float* PSV, const float* wsh, const float* bsh, const float* gn, int tid) {
    LAS bf16* As = (LAS bf16*)lds;
    LAS bf16* Vt = (LAS bf16*)(lds + 34816);
    LAS float* rs = (LAS float*)(lds + 69632);
    const int R0 = c * CHUNK, C0 = h * 128;
    { const int r = tid >> 2, q4 = tid & 3; float s = pg8::sum4(*(const f32x4*)(PSV + (size_t)(R0 + r) * 16 + 4 * q4)); s += __shfl_xor(s, 1); s += __shfl_xor(s, 2);
      if (q4 == 0) rs[r] = rsqrtf(s * (1.0f / 1024.0f) + EPS); }
    __syncthreads();
#pragma unroll
    for (int i = 0; i < 4; ++i) { const int it = tid + i * NTHREADS, q = it >> 4, p8 = (it & 15) * 8; const float* src = wsh + q * 128 + p8;
        f32x4 x0 = *(const f32x4*)src, x1 = *(const f32x4*)(src + 4); const f32x4 r0 = *(const LAS f32x4*)(rs + p8), r1 = *(const LAS f32x4*)(rs + p8 + 4);
        *(LAS u32x4*)(As + q * 136 + p8) = pg8::pack8(x0 * r0, x1 * r1); }
#pragma unroll
    for (int i = 0; i < 4; ++i) { const int it = tid + i * NTHREADS, p = it & 127, d8 = (it >> 7) * 8;
        const u32x4 v = *(const u32x4*)(V + (size_t)(R0 + p) * D + C0 + d8); LAS bf16* dst = Vt + d8 * 136 + p;
        dst[0 * 136] = (bf16)(v.x & 0xffffu); dst[1 * 136] = (bf16)(v.x >> 16); dst[2 * 136] = (bf16)(v.y & 0xffffu); dst[3 * 136] = (bf16)(v.y >> 16);
        dst[4 * 136] = (bf16)(v.z & 0xffffu); dst[5 * 136] = (bf16)(v.z >> 16); dst[6 * 136] = (bf16)(v.w & 0xffffu); dst[7 * 136] = (bf16)(v.w >> 16); }
    __syncthreads();
    const int wid = tid >> 6, lane = tid & 63, wr = wid >> 2, wc = wid & 3, fr = lane & 15, fq = lane >> 4;
    f32x4 acc[4][2];
#pragma unroll
    for (int m = 0; m < 4; ++m)
#pragma unroll
        for (int n = 0; n < 2; ++n) acc[m][n] = (f32x4){0.f, 0.f, 0.f, 0.f};
#pragma unroll
    for (int kk = 0; kk < 4; ++kk) { bf16x8 af[4], bf[2];
#pragma unroll
        for (int m = 0; m < 4; ++m) af[m] = *(const LAS bf16x8*)(As + (wr * 64 + m * 16 + fr) * 136 + kk * 32 + fq * 8);
#pragma unroll
        for (int n = 0; n < 2; ++n) bf[n] = *(const LAS bf16x8*)(Vt + (wc * 32 + n * 16 + fr) * 136 + kk * 32 + fq * 8);
#pragma unroll
        for (int m = 0; m < 4; ++m)
#pragma unroll
            for (int n = 0; n < 2; ++n) acc[m][n] = __builtin_amdgcn_mfma_f32_16x16x32_bf16(bf[n], af[m], acc[m][n], 0, 0, 0); }
#pragma unroll
    for (int m = 0; m < 4; ++m) { const int q = wr * 64 + m * 16 + fr; const float bq = bsh[q];
#pragma unroll
        for (int n = 0; n < 2; ++n) { const int d = wc * 32 + n * 16 + 4 * fq; bf16* up = U + (size_t)(R0 + q) * D + C0 + d;
            const u32x2 uw = *(const u32x2*)up; const f32x4 g = *(const f32x4*)(gn + d);
            const f32x4 uu = (f32x4){pg8::bflo(uw.x), pg8::bfhi(uw.x), pg8::bflo(uw.y), pg8::bfhi(uw.y)};
            const f32x4 o = uu * (g * acc[m][n] + bq);
            u32x2 w; w.x = pg8::cvt_pk_bf16(o[0], o[1]); w.y = pg8::cvt_pk_bf16(o[2], o[3]); *(u32x2*)up = w; } }
    __syncthreads();
}

__device__ __forceinline__ void conv_phase(bf16* GB, const bf16* T, const float* cw, int gtid, int nthr) {
    for (int it = gtid; it < M * (D / 8); it += nthr) { const int row = it >> 7, c8 = (it & 127) * 8, s = row & (SEQ - 1); const size_t off = (size_t)row * D + c8;
        f32x4 a0, a1, b0, b1, c0, c1, g0, g1;
        pg8::unpack8(*(const u32x4*)(T + off), b0, b1); pg8::unpack8(*(const u32x4*)(GB + off), g0, g1);
        if (s > 0) pg8::unpack8(*(const u32x4*)(T + off - D), a0, a1); else { a0 = (f32x4){0.f, 0.f, 0.f, 0.f}; a1 = a0; }
        if (s < SEQ - 1) pg8::unpack8(*(const u32x4*)(T + off + D), c0, c1); else { c0 = (f32x4){0.f, 0.f, 0.f, 0.f}; c1 = c0; }
        const f32x4 w00 = *(const f32x4*)(cw + c8), w01 = *(const f32x4*)(cw + c8 + 4), w10 = *(const f32x4*)(cw + D + c8), w11 = *(const f32x4*)(cw + D + c8 + 4), w20 = *(const f32x4*)(cw + 2 * D + c8), w21 = *(const f32x4*)(cw + 2 * D + c8 + 4);
        *(u32x4*)(GB + off) = pg8::pack8(g0 * (w00 * a0 + w10 * b0 + w20 * c0), g1 * (w01 * a1 + w11 * b1 + w21 * c1)); }
}

__device__ __forceinline__ void final_phase(float* out, const float* g, int gw, int NGW, int lane) {
    f32x4 gv[4];
#pragma unroll
    for (int j = 0; j < 4; ++j) gv[j] = ((const f32x4*)g)[lane + 64 * j];
    for (int m = gw; m < M; m += NGW) { f32x4* xr = (f32x4*)(out + (size_t)m * D) + lane; f32x4 v[4]; float s = 0.f;
#pragma unroll
        for (int j = 0; j < 4; ++j) { v[j] = xr[64 * j]; s += pg8::dot4(v[j]); }
        const float rs = rsqrtf(wave_sum(s) * (1.0f / D) + EPS);
#pragma unroll
        for (int j = 0; j < 4; ++j) xr[64 * j] = v[j] * rs * gv[j]; }
}

#ifndef EN_MASK
#define EN_MASK 63
#endif
#define EN(k) ((EN_MASK >> (k)) & 1)
constexpr int N_PHASES = 2 + 8 * DEPTH;

typedef const __attribute__((address_space(4))) Args* KArgs;
__global__ void __launch_bounds__(NTHREADS, 2) fwd(Args a_unused) {
    extern __shared__ __attribute__((aligned(16))) unsigned char lds_raw[];
    LAS unsigned char* lds = (LAS unsigned char*)lds_raw;
    KArgs kap = (KArgs)__builtin_amdgcn_kernarg_segment_ptr();
    const int ph_lo = kap->ph_lo, ph_hi = kap->ph_hi;
#if MK_XCDBAR
    for (int u = threadIdx.x; u < (LDS_BYTES - MISC_OFF) / 4; u += NTHREADS) ((LAS unsigned*)(lds + MISC_OFF))[u] = 0u;
    __syncthreads();
    XcdBarrier bar = xcd_barrier_post((unsigned*)(kap->ws + WS_CTL) + 4096, (volatile LAS unsigned*)(lds + MISC_OFF) + 8);
#endif
    for (int ph = ph_lo; ph < ph_hi; ++ph) {
        if (ph > ph_lo) {
#if MK_XCDBAR
            if (ph == ph_lo + 1) cg::this_grid().sync(); else xcd_barrier(bar);
#else
            cg::this_grid().sync();
#endif
        }
        KArgs ap = kap; asm volatile("" : "+s"(ap));
        int tid = threadIdx.x; asm volatile("" : "+v"(tid));
        const int lane = tid & 63, wave = __builtin_amdgcn_readfirstlane(tid >> 6);
        const int G = gridDim.x, bx = blockIdx.x;
        const int gw = bx * NWAVES + wave, NGW = G * NWAVES;
        unsigned char* ws = ap->ws;
        bf16* XB = (bf16*)(ws + WS_XB); float* PS = (float*)(ws + WS_PS); float* PSV = (float*)(ws + WS_PSV);
        unsigned char* act = ws + WS_ACT;
        bf16* Hb = (bf16*)(act + A_H); bf16* Ub = (bf16*)(act + A_U); bf16* Vb = (bf16*)(act + A_V); bf16* Tb = (bf16*)(act + A_T); bf16* GBb = (bf16*)(act + A_GB); bf16* SAb = (bf16*)(act + A_SA); bf16* SBb = (bf16*)(act + A_SB);
        float* ST = (float*)(act + A_V);
        const bf16* WB = (const bf16*)(ws + WS_W);
        if (EN(5) && ph == 0) { prologue(ap, lds, gw, NGW, wave, lane); continue; }
        if (ph == N_PHASES - 1) { final_phase(ap->out, ap->in[I_FN], gw, NGW, lane); continue; }
        const int l = (ph - 1) >> 3, kind = (ph - 1) & 7;
        const bf16* wl = WB + (size_t)l * E_LAYER;
        if (EN(0) && (kind == 0 || kind == 6)) {
            pg8::Gemm g{XB, wl + (kind == 0 ? O_F1I : O_F2I), M, 2 * FF, D}; pg8::StaticOrder S; S.init(M, 2 * FF, G, bx);
            pg8::EpiFfnUp E{Hb, PS};
            pg8::gemm_phase<pg8::EpiFfnUp, pg8::StaticOrder, true, true>(lds, g, S, E);
        } else if (EN(1) && (kind == 1 || kind == 7 || kind == 5)) {
            const bool ffn = kind != 5;
            pg8::Gemm g{ffn ? Hb : SAb, wl + (kind == 1 ? O_F1O : (kind == 7 ? O_F2O : O_WO)), M, D, ffn ? FF : D}; pg8::StaticOrder S; S.init(M, D, G, bx);
            pg8::EpiResid E{(l == 0 && kind == 1) ? ap->in[I_X] : ap->out, ap->out, XB, PS, ffn ? 0.5f : 1.0f};
            pg8::gemm_phase<pg8::EpiResid, pg8::StaticOrder, false, true>(lds, g, S, E);
        } else if (EN(2) && kind == 2) {
            pg8::Gemm g{XB, wl + O_WIN, M, NIN, D}; pg8::StaticOrder S; S.init(M, NIN, G, bx);
            pg8::EpiMixIn E{Ub, Vb, Tb, GBb, SAb, SBb, PS, PSV};
            pg8::gemm_phase<pg8::EpiMixIn, pg8::StaticOrder, true, true>(lds, g, S, E);
        } else if (EN(3) && kind == 3) {
            for (int t = bx; t < (M / CHUNK) * HEADS; t += G) { const int c = t >> 3, h = t & 7;
                sgu_tile(lds, c, h, Ub, Vb, PSV, ap->in[I_SGW] + ((size_t)l * HEADS + h) * CHUNK * CHUNK, ap->in[I_SGB] + ((size_t)l * HEADS + h) * CHUNK, ap->in[I_SGN] + (size_t)l * D + h * 128, tid); }
            conv_phase(GBb, Tb, ap->in[I_CW] + (size_t)l * 3 * D, bx * NTHREADS + tid, G * NTHREADS);
        } else if (EN(4) && kind == 4) {
            pg8::StaticOrder S; S.init(M, D, G, bx);
            { pg8::Gemm g{Ub, wl + O_PA, M, D, D}; pg8::EpiProjA E{SAb, ST}; pg8::gemm_phase<pg8::EpiProjA, pg8::StaticOrder, false, true>(lds, g, S, E); }
            { pg8::Gemm g{GBb, wl + O_PB, M, D, D}; pg8::EpiProjB E{SBb, ST, SAb}; pg8::gemm_phase<pg8::EpiProjB, pg8::StaticOrder, false, true>(lds, g, S, E); }
        }
    }
}

extern "C" void kernel_launch(void* const* d_in, const int* in_sizes, int n_in, void* d_out, int out_size, void* d_ws, size_t ws_size, hipStream_t stream) {
    static int state = 0;
    if (state == 0) {
        if (n_in != 17 || in_sizes[0] != M * D || out_size != M * D || ws_size < WS_END) { fprintf(stderr, "kernel_launch: unexpected shapes (n_in %d, in0 %d, out %d, ws %zu < %zu)\n", n_in, n_in > 0 ? in_sizes[0] : -1, out_size, ws_size, (size_t)WS_END); state = -1; return; }
        if (hipFuncSetAttribute((const void*)fwd, hipFuncAttributeMaxDynamicSharedMemorySize, LDS_BYTES) != hipSuccess) { fprintf(stderr, "kernel_launch: hipFuncSetAttribute failed\n"); state = -1; return; }
        state = 1;
    }
    if (state < 0) return;
    (void)hipMemsetAsync((char*)d_ws + WS_CTL, 0, CTL_BYTES, stream);
    Args a{};
    for (int i = 0; i < 17; ++i) a.in[i] = (const float*)d_in[i];
    a.out = (float*)d_out; a.ws = (unsigned char*)d_ws;
#if MK_SINGLE
    a.ph_lo = 0; a.ph_hi = N_PHASES;
    void* params[] = {&a};
    hipError_t e = hipLaunchCooperativeKernel((const void*)fwd, dim3(256), dim3(NTHREADS), params, LDS_BYTES, stream);
    if (e != hipSuccess) fprintf(stderr, "kernel_launch: cooperative launch failed: %s\n", hipGetErrorString(e));
#else
    for (int ph = 0; ph < N_PHASES; ++ph) { a.ph_lo = ph; a.ph_hi = ph + 1; hipLaunchKernelGGL(fwd, dim3(256), dim3(NTHREADS), LDS_BYTES, stream, a); }
#endif
}
```

```cpp
#include <hip/hip_runtime.h>
#include <hip/hip_cooperative_groups.h>
#include <cstdio>
#include <cstdint>
namespace cg = cooperative_groups;

#ifndef MK_SINGLE
#define MK_SINGLE 1
#endif
#ifndef MK_XCDBAR
#define MK_XCDBAR 1
#endif

constexpr int BATCH = 8, SEQ = 2048, D = 1024, DEPTH = 4, FF = 2816, NIN = 7168, CHUNK = 128, HEADS = 8;
constexpr int M = BATCH * SEQ;
constexpr float EPS = 1e-6f;
constexpr bool USE_XL = false;

namespace pg8 {
#define PG8_LAS __attribute__((address_space(3)))
typedef unsigned short bf16_t;
typedef short bf16x8 __attribute__((ext_vector_type(8)));
typedef float f32x4 __attribute__((ext_vector_type(4)));
typedef unsigned u32x4 __attribute__((ext_vector_type(4)));
constexpr int BM = 256, BK = 64, HALF = 128, HTB = HALF * BK * 2  , STAGE_BYTES = 8 * HTB, NXCD = 8, WGM = 8;

__host__ __device__ __forceinline__ int lds_byte(int r, int c) { const int st = (r >> 4) * 2 + (c >> 5), rr = r & 15, cc = c & 31, ob = rr * 64 + cc * 2; return st * 1024 + (ob ^ (((ob >> 9) & 1) << 5)); }
__host__ __device__ __forceinline__ void stage_rc(int b, int& R, int& C) { const int st = b / 1024, sb = b % 1024, swz = sb ^ (((sb >> 9) & 1) << 5); R = (st >> 1) * 16 + swz / 64; C = (st & 1) * 32 + (swz % 64) / 2; }
__host__ __device__ __forceinline__ int perm32(int rho) { const int n = rho >> 4, i = rho & 15; return 8 * (i >> 2) + 4 * n + (i & 3); }

struct Unit { int pm, pn; };
struct Gemm { const bf16_t* A; const bf16_t* Bt; int M, N, K; const bf16_t* A2; const bf16_t* Bt2; int ksplit, lda, ldb; };

struct StaticOrder {
    int nM, nN, nwg, G, c;
    __host__ __device__ void init(int M, int N, int G_, int c_) { nM = M / BM; nN = N / BM; nwg = nM * nN; G = G_; c = c_; }
    __host__ __device__ bool next(int i, Unit& u) const {
        if (nM == 64 && G == 256) {
            u.pm = 8 * (c & 7) + ((c >> 3) & 7); u.pn = 4 * i + (c >> 6); return u.pn < nN; }
        const long L = (long)i * G + c; if (L >= nwg) return false;
        int wgid = (int)L; { const int q = nwg / NXCD, r = nwg % NXCD, xcd = wgid % NXCD, off = wgid / NXCD; wgid = (xcd < r ? xcd * (q + 1) : r * (q + 1) + (xcd - r) * q) + off; }
        const int nig = WGM * nN, gid = wgid / nig, fm = gid * WGM, gsz = (nM - fm) < WGM ? (nM - fm) : WGM;
        u.pm = fm + ((wgid % nig) % gsz); u.pn = (wgid % nig) / gsz; return true;
    }
    __device__ __forceinline__ void a_ready(const Unit&) const {}
    __device__ __forceinline__ void done(const Unit&) const {}
};
typedef _Float16 h2_t __attribute__((ext_vector_type(2))); typedef _Float16 h8_t __attribute__((ext_vector_type(8)));
__device__ __forceinline__ unsigned cvt_pk_bf16(float lo, float hi) { unsigned r; asm volatile("v_cvt_pk_bf16_f32 %0, %1, %2" : "=v"(r) : "v"(lo), "v"(hi)); return r; }
typedef unsigned u32x2 __attribute__((ext_vector_type(2)));
__device__ __forceinline__ float fsigmoid(float x) { return __builtin_amdgcn_rcpf(1.0f + __builtin_amdgcn_exp2f(-1.44269504089f * x)); }
__device__ __forceinline__ float fsilu(float x) { return x * fsigmoid(x); }
__device__ __forceinline__ float fgelu(float x) { return x * fsigmoid(1.59576912161f * (x + 0.044715f * x * x * x)); }
__device__ __forceinline__ f32x4 vexp2(const f32x4 t) { return (f32x4){__builtin_amdgcn_exp2f(t[0]), __builtin_amdgcn_exp2f(t[1]), __builtin_amdgcn_exp2f(t[2]), __builtin_amdgcn_exp2f(t[3])}; }
__device__ __forceinline__ f32x4 vrcp(const f32x4 t) { return (f32x4){__builtin_amdgcn_rcpf(t[0]), __builtin_amdgcn_rcpf(t[1]), __builtin_amdgcn_rcpf(t[2]), __builtin_amdgcn_rcpf(t[3])}; }
__device__ __forceinline__ f32x4 vsig_from_t(const f32x4 t) { return vrcp(vexp2(t) + 1.0f); }
__device__ __forceinline__ f32x4 vgelu(const f32x4 x) { const f32x4 w = (x * x) * (-0.10294324f) + (-2.30220819f); return x * vsig_from_t(w * x); }
typedef __amdgpu_buffer_rsrc_t rsrc_t;
__device__ __forceinline__ rsrc_t mk_rsrc(const void* p, size_t bytes) { return __builtin_amdgcn_make_buffer_rsrc((void*)p, 0, (int)bytes, 0x00020000); }
__device__ __forceinline__ void st16_wt(const rsrc_t r, size_t byte_off, const u32x4 v) { __builtin_amdgcn_raw_buffer_store_b128(v, r, (unsigned)byte_off, 0,   16); }
__device__ __forceinline__ u32x4 ld16_b(const rsrc_t r, unsigned voff, unsigned soff) { return __builtin_amdgcn_raw_buffer_load_b128(r, voff, soff, 0); }
__device__ __forceinline__ float bflo(unsigned w) { return __uint_as_float(w << 16); }
__device__ __forceinline__ float bfhi(unsigned w) { return __uint_as_float(w & 0xffff0000u); }
__device__ __forceinline__ u32x4 pack8(const f32x4 a, const f32x4 b) { u32x4 w; w.x = cvt_pk_bf16(a[0], a[1]); w.y = cvt_pk_bf16(a[2], a[3]); w.z = cvt_pk_bf16(b[0], b[1]); w.w = cvt_pk_bf16(b[2], b[3]); return w; }
__device__ __forceinline__ void unpack8(const u32x4 w, f32x4& a, f32x4& b) { a = (f32x4){bflo(w.x), bfhi(w.x), bflo(w.y), bfhi(w.y)}; b = (f32x4){bflo(w.z), bfhi(w.z), bflo(w.w), bfhi(w.w)}; }
__device__ __forceinline__ float sum4(const f32x4 v) { return (v[0] + v[1]) + (v[2] + v[3]); }
__device__ __forceinline__ float dot4(const f32x4 v) { return (v[0] * v[0] + v[1] * v[1]) + (v[2] * v[2] + v[3] * v[3]); }
__device__ __forceinline__ float row_rstd(const float* PS, int row, int fq) {
    float s = sum4(*(const f32x4*)(PS + (size_t)row * 16 + 4 * fq)); s += __shfl_xor(s, 16); s += __shfl_xor(s, 32);
    return rsqrtf(s * (1.0f / 1024.0f) + EPS);
}

#define PIN8(a) asm volatile("" : "+v"(a[0][0]), "+v"(a[0][1]), "+v"(a[0][2]), "+v"(a[0][3]), "+v"(a[1][0]), "+v"(a[1][1]), "+v"(a[1][2]), "+v"(a[1][3]) :: "memory")
#define PIN16(a) asm volatile("" : "+v"(a[0][0][0]), "+v"(a[0][0][1]), "+v"(a[0][1][0]), "+v"(a[0][1][1]), "+v"(a[0][2][0]), "+v"(a[0][2][1]), "+v"(a[0][3][0]), "+v"(a[0][3][1]), \
                                    "+v"(a[1][0][0]), "+v"(a[1][0][1]), "+v"(a[1][1][0]), "+v"(a[1][1][1]), "+v"(a[1][2][0]), "+v"(a[1][2][1]), "+v"(a[1][3][0]), "+v"(a[1][3][1]) :: "memory")
__device__ __forceinline__ void rows_rstd(const PG8_LAS float* RS, int wr, int fr, float (&rs)[2][4]) {
#pragma unroll
    for (int ai = 0; ai < 2; ++ai)
#pragma unroll
        for (int m = 0; m < 4; ++m) rs[ai][m] = RS[wr * 64 + ai * HALF + m * 16 + fr];
}

struct EpiFfnUp {
    static constexpr bool PERM = true, AFTER_DRAIN = false, INIT_ACC = false, HAS_MID = false;
    bf16_t* H; const PG8_LAS float* RS; bool skip;
    __device__ __forceinline__ void operator()(const f32x4 (&acc)[2][2][4][2], const Unit& u, int wr, int wc, int fr, int fq) const {
        const int row0 = u.pm * BM + wr * 64 + fr, col0 = u.pn * 128 + wc * 32 + 8 * fq;
        if (skip) { if (acc[0][0][0][0][0] == 123.456f) H[row0] = 0; return; }
        float rs[2][4]; rows_rstd(RS, wr, fr, rs);
        const rsrc_t rH = mk_rsrc(H, (size_t)M * FF * 2);
#pragma unroll
        for (int ai = 0; ai < 2; ++ai)
#pragma unroll
            for (int m = 0; m < 4; ++m) { const int row = row0 + ai * HALF + m * 16; const float r = rs[ai][m];
                const float c = -1.44269504089f * r, r2 = r * r;
                const f32x4 h0 = (acc[ai][0][m][0] * acc[ai][1][m][0]) * (vsig_from_t(acc[ai][0][m][0] * c) * r2), h1 = (acc[ai][0][m][1] * acc[ai][1][m][1]) * (vsig_from_t(acc[ai][0][m][1] * c) * r2);
                st16_wt(rH, ((size_t)row * FF + col0) * 2, pack8(h0, h1)); }
    }
};
struct EpiResid {
    static constexpr bool PERM = true, AFTER_DRAIN = false, INIT_ACC = true, HAS_MID = false;
    bf16_t* XH; bf16_t* XL; float* PS; float scale, inv_scale;
    __device__ __forceinline__ void init(f32x4 (&acc)[2][2][4][2], const Unit& u, int wr, int wc, int fr, int fq) const {
        const int row0 = u.pm * BM + wr * 64 + fr, col0 = u.pn * BM + wc * 32 + 8 * fq;
#pragma unroll
        for (int ai = 0; ai < 2; ++ai)
#pragma unroll
            for (int m = 0; m < 4; ++m)
#pragma unroll
                for (int bj = 0; bj < 2; ++bj) { const size_t off = (size_t)(row0 + ai * HALF + m * 16) * D + col0 + bj * HALF;
                    f32x4 h0, h1, l0 = (f32x4){0.f, 0.f, 0.f, 0.f}, l1 = l0; unpack8(*(const u32x4*)(XH + off), h0, h1); if (USE_XL) unpack8(*(const u32x4*)(XL + off), l0, l1);
                    acc[ai][bj][m][0] = (h0 + l0) * inv_scale; acc[ai][bj][m][1] = (h1 + l1) * inv_scale; }
    }
    __device__ __forceinline__ void operator()(const f32x4 (&acc)[2][2][4][2], const Unit& u, int wr, int wc, int fr, int fq) const {
        const int row0 = u.pm * BM + wr * 64 + fr, col0 = u.pn * BM + wc * 32 + 8 * fq;
        const rsrc_t rXH = mk_rsrc(XH, (size_t)M * D * 2), rXL = mk_rsrc(XL, (size_t)M * D * 2);
#pragma unroll
        for (int ai = 0; ai < 2; ++ai)
#pragma unroll
            for (int m = 0; m < 4; ++m) { const int row = row0 + ai * HALF + m * 16; float ss = 0.f;
#pragma unroll
                for (int bj = 0; bj < 2; ++bj) { const size_t off = (size_t)row * D + col0 + bj * HALF;
                    const f32x4 a = acc[ai][bj][m][0] * scale, b = acc[ai][bj][m][1] * scale; ss += dot4(a) + dot4(b);
                    const u32x4 hi = pack8(a, b); f32x4 ha, hb; unpack8(hi, ha, hb);
                    st16_wt(rXH, off * 2, hi); if (USE_XL) st16_wt(rXL, off * 2, pack8(a - ha, b - hb)); }
                ss += __shfl_xor(ss, 16); ss += __shfl_xor(ss, 32);
                if (fq == 0) PS[(size_t)row * 16 + u.pn * 4 + wc] = ss; }
    }
};
struct EpiResidF32 {
    static constexpr bool PERM = true, AFTER_DRAIN = false, INIT_ACC = true, HAS_MID = false;
    const float* xs; float* xd; bf16_t* XB; float* PS; float scale, inv_scale;
    __device__ __forceinline__ void init(f32x4 (&acc)[2][2][4][2], const Unit& u, int wr, int wc, int fr, int fq) const {
        const int row0 = u.pm * BM + wr * 64 + fr, col0 = u.pn * BM + wc * 32 + 8 * fq;
#pragma unroll
        for (int ai = 0; ai < 2; ++ai)
#pragma unroll
            for (int m = 0; m < 4; ++m)
#pragma unroll
                for (int bj = 0; bj < 2; ++bj) { const size_t off = (size_t)(row0 + ai * HALF + m * 16) * D + col0 + bj * HALF;
                    acc[ai][bj][m][0] = *(const f32x4*)(xs + off) * inv_scale; acc[ai][bj][m][1] = *(const f32x4*)(xs + off + 4) * inv_scale; }
    }
    __device__ __forceinline__ void operator()(const f32x4 (&acc)[2][2][4][2], const Unit& u, int wr, int wc, int fr, int fq) const {
        const int row0 = u.pm * BM + wr * 64 + fr, col0 = u.pn * BM + wc * 32 + 8 * fq;
#pragma unroll
        for (int ai = 0; ai < 2; ++ai)
#pragma unroll
            for (int m = 0; m < 4; ++m) { const int row = row0 + ai * HALF + m * 16; float ss = 0.f;
#pragma unroll
                for (int bj = 0; bj < 2; ++bj) { const size_t off = (size_t)row * D + col0 + bj * HALF;
                    const f32x4 a = acc[ai][bj][m][0] * scale, b = acc[ai][bj][m][1] * scale;
                    *(f32x4*)(xd + off) = a; *(f32x4*)(xd + off + 4) = b; ss += dot4(a) + dot4(b);
                    *(u32x4*)(XB + off) = pack8(a, b); }
                ss += __shfl_xor(ss, 16); ss += __shfl_xor(ss, 32);
                if (fq == 0) PS[(size_t)row * 16 + u.pn * 4 + wc] = ss; }
    }
};
struct EpiMixIn {
    static constexpr bool PERM = true, AFTER_DRAIN = false, INIT_ACC = false, HAS_MID = false;
    bf16_t *U, *V, *T, *GB, *SA, *SB; const PG8_LAS float* RS; float* PSV;
    __device__ __forceinline__ void operator()(const f32x4 (&acc)[2][2][4][2], const Unit& u, int wr, int wc, int fr, int fq) const {
        const int pn = u.pn, row0 = u.pm * BM + wr * 64 + fr, cw = wc * 32 + 8 * fq;
        float rs[2][4]; rows_rstd(RS, wr, fr, rs);
        if (pn >= 12 && pn < 20) {
            const int col = (pn - 12) * 128 + cw; const rsrc_t rT = mk_rsrc(T, (size_t)M * D * 2);
#pragma unroll
            for (int ai = 0; ai < 2; ++ai)
#pragma unroll
                for (int m = 0; m < 4; ++m) { const int row = row0 + ai * HALF + m * 16; const float r2 = rs[ai][m] * rs[ai][m];
                    const f32x4 t0 = acc[ai][0][m][0] * acc[ai][1][m][0] * r2, t1 = acc[ai][0][m][1] * acc[ai][1][m][1] * r2;
                    st16_wt(rT, ((size_t)row * D + col) * 2, pack8(t0, t1)); }
        } else {
            bf16_t* O; int cb, act;
            if (pn < 4) { O = U; cb = pn * 256; act = 1; } else if (pn < 8) { O = V; cb = (pn - 4) * 256; act = 2; } else if (pn < 12) { O = GB; cb = (pn - 8) * 256; act = 0; }
            else if (pn < 24) { O = SA; cb = (pn - 20) * 256; act = 3; } else { O = SB; cb = (pn - 24) * 256; act = 3; }
            const rsrc_t rO = mk_rsrc(O, (size_t)M * D * 2);
#pragma unroll
            for (int ai = 0; ai < 2; ++ai)
#pragma unroll
                for (int m = 0; m < 4; ++m) { const int row = row0 + ai * HALF + m * 16; const float r = rs[ai][m]; float ss = 0.f;
#pragma unroll
                    for (int bj = 0; bj < 2; ++bj) { f32x4 v0 = acc[ai][bj][m][0] * r, v1 = acc[ai][bj][m][1] * r;
                        if (act == 1 || act == 2) { v0 = vgelu(v0); v1 = vgelu(v1); ss += dot4(v0) + dot4(v1); }
                        else if (act == 3) { v0 = vsig_from_t(v0 * (-1.44269504089f)); v1 = vsig_from_t(v1 * (-1.44269504089f)); }
                        st16_wt(rO, ((size_t)row * D + cb + bj * HALF + cw) * 2, pack8(v0, v1)); }
                    if (act == 2) { ss += __shfl_xor(ss, 16); ss += __shfl_xor(ss, 32); if (fq == 0) PSV[(size_t)row * 16 + (pn - 4) * 4 + wc] = ss; } }
        }
    }
};
struct EpiGate {
    static constexpr bool PERM = true, AFTER_DRAIN = false, INIT_ACC = false, HAS_MID = false;
    const bf16_t* GATE; bf16_t* O; int coff;
    __device__ __forceinline__ void operator()(const f32x4 (&acc)[2][2][4][2], const Unit& u, int wr, int wc, int fr, int fq) const {
        const int row0 = u.pm * BM + wr * 64 + fr, col0 = u.pn * BM + wc * 32 + 8 * fq;
        u32x4 g[2][4][2];
#pragma unroll
        for (int ai = 0; ai < 2; ++ai)
#pragma unroll
            for (int m = 0; m < 4; ++m)
#pragma unroll
                for (int bj = 0; bj < 2; ++bj) g[ai][m][bj] = *(const u32x4*)(GATE + (size_t)(row0 + ai * HALF + m * 16) * D + col0 + bj * HALF);
        PIN16(g);
#pragma unroll
        for (int ai = 0; ai < 2; ++ai)
#pragma unroll
            for (int m = 0; m < 4; ++m)
#pragma unroll
                for (int bj = 0; bj < 2; ++bj) { f32x4 g0, g1; unpack8(g[ai][m][bj], g0, g1);
                    *(u32x4*)(O + (size_t)(row0 + ai * HALF + m * 16) * (2 * D) + coff + col0 + bj * HALF) = pack8(g0 * acc[ai][bj][m][0], g1 * acc[ai][bj][m][1]); }
    }
};

struct EpiProj {
    static constexpr bool PERM = true, AFTER_DRAIN = false, INIT_ACC = false, HAS_MID = false;
    const bf16_t* GATE; bf16_t* ST; bf16_t* MG; bool second;
    __device__ __forceinline__ void operator()(const f32x4 (&acc)[2][2][4][2], const Unit& u, int wr, int wc, int fr, int fq) const {
        const int row0 = u.pm * BM + wr * 64 + fr, col0 = u.pn * BM + wc * 32 + 8 * fq;
        u32x4 w[2][4][2];
#pragma unroll
        for (int ai = 0; ai < 2; ++ai) {
            u32x4 g[4][2], p[4][2];
#pragma unroll
            for (int m = 0; m < 4; ++m)
#pragma unroll
                for (int bj = 0; bj < 2; ++bj) { const size_t off = (size_t)(row0 + ai * HALF + m * 16) * D + col0 + bj * HALF;
                    g[m][bj] = *(const u32x4*)(GATE + off); p[m][bj] = second ? *(const u32x4*)(ST + off) : (u32x4){0u, 0u, 0u, 0u}; }
#pragma unroll
            for (int m = 0; m < 4; ++m)
#pragma unroll
                for (int bj = 0; bj < 2; ++bj) { f32x4 g0, g1, p0, p1; unpack8(g[m][bj], g0, g1); unpack8(p[m][bj], p0, p1);
                    w[ai][m][bj] = pack8(p0 + g0 * acc[ai][bj][m][0], p1 + g1 * acc[ai][bj][m][1]); }
            asm volatile("" ::: "memory");
        }
        PIN16(w);
        const rsrc_t rO = mk_rsrc(second ? MG : ST, (size_t)M * D * 2);
#pragma unroll
        for (int ai = 0; ai < 2; ++ai)
#pragma unroll
            for (int m = 0; m < 4; ++m)
#pragma unroll
                for (int bj = 0; bj < 2; ++bj) st16_wt(rO, ((size_t)(row0 + ai * HALF + m * 16) * D + col0 + bj * HALF) * 2, w[ai][m][bj]);
    }
};

struct EpiMerge {
    static constexpr bool PERM = true, AFTER_DRAIN = false, INIT_ACC = false, HAS_MID = true;
    const bf16_t* SA; const bf16_t* SB; bf16_t* MG;
    __device__ __forceinline__ void mid(f32x4 (&acc)[2][2][4][2], const Unit& u, int wr, int wc, int fr, int fq) const {
        const int row0 = u.pm * BM + wr * 64 + fr, col0 = u.pn * BM + wc * 32 + 8 * fq;
        const rsrc_t rA = mk_rsrc(SA, (size_t)M * D * 2), rB = mk_rsrc(SB, (size_t)M * D * 2);
        const unsigned voff = (unsigned)((size_t)row0 * D + col0) * 2u;
#pragma unroll
        for (int ai = 0; ai < 2; ++ai) {
            u32x4 ga[4][2], gb[4][2];
#pragma unroll
            for (int m = 0; m < 4; ++m)
#pragma unroll
                for (int bj = 0; bj < 2; ++bj) { const unsigned so = (unsigned)(((ai * HALF + m * 16) * D + bj * HALF) * 2); ga[m][bj] = ld16_b(rA, voff, so); gb[m][bj] = ld16_b(rB, voff, so); }
#pragma unroll
            for (int m = 0; m < 4; ++m)
#pragma unroll
                for (int bj = 0; bj < 2; ++bj) { f32x4 a0, a1, b0, b1; unpack8(ga[m][bj], a0, a1); unpack8(gb[m][bj], b0, b1);
                    acc[ai][bj][m][0] = acc[ai][bj][m][0] * (a0 * vrcp(b0)); acc[ai][bj][m][1] = acc[ai][bj][m][1] * (a1 * vrcp(b1)); }
            asm volatile("" ::: "memory"); }
    }
    __device__ __forceinline__ void operator()(const f32x4 (&acc)[2][2][4][2], const Unit& u, int wr, int wc, int fr, int fq) const {
        const int row0 = u.pm * BM + wr * 64 + fr, col0 = u.pn * BM + wc * 32 + 8 * fq;
        u32x4 g[2][4][2];
#pragma unroll
        for (int ai = 0; ai < 2; ++ai)
#pragma unroll
            for (int m = 0; m < 4; ++m)
#pragma unroll
                for (int bj = 0; bj < 2; ++bj) g[ai][m][bj] = *(const u32x4*)(SB + (size_t)(row0 + ai * HALF + m * 16) * D + col0 + bj * HALF);
        PIN16(g);
        const rsrc_t rO = mk_rsrc(MG, (size_t)M * D * 2);
#pragma unroll
        for (int ai = 0; ai < 2; ++ai)
#pragma unroll
            for (int m = 0; m < 4; ++m)
#pragma unroll
                for (int bj = 0; bj < 2; ++bj) { f32x4 b0, b1; unpack8(g[ai][m][bj], b0, b1);
                    st16_wt(rO, ((size_t)(row0 + ai * HALF + m * 16) * D + col0 + bj * HALF) * 2, pack8(b0 * acc[ai][bj][m][0], b1 * acc[ai][bj][m][1])); }
    }
};

template <class Epi, class Sched, bool ALIGN_EPI = false, bool SP2 = false>
__device__ __forceinline__ void gemm_phase(PG8_LAS unsigned char* lds, const Gemm g, const Sched& S, const Epi& E) {
    int tid_ = threadIdx.x; asm volatile("" : "+v"(tid_));
    const int tid = tid_, wid = __builtin_amdgcn_readfirstlane(tid >> 6), lane = tid & 63, wr = wid >> 2, wc = wid & 3, fr = lane & 15, fq = lane >> 4;
    const int K = g.K, nt = K / BK, lda = g.lda ? g.lda : K, ldb = g.ldb ? g.ldb : K, ks = g.ksplit;
    unsigned voffA[2], voffB[2];
#pragma unroll
    for (int i = 0; i < 2; ++i) { int R, C; stage_rc(tid * 16 + i * 8192, R, C); const int Rb = Epi::PERM ? ((R & ~31) + perm32(R & 31)) : R;
        voffA[i] = (unsigned)(R * lda + C) * 2u; voffB[i] = (unsigned)(Rb * ldb + C) * 2u; }
    const size_t kstep = (size_t)(BK * 2);
    const size_t hstepA = (size_t)HALF * lda * 2, hstepB = (size_t)HALF * ldb * 2;
    const size_t tstepA = 2 * hstepA, tstepB = 2 * hstepB;
    const unsigned ldsw = (unsigned)wid * 1024u;
    const int aoff = lds_byte(wr * 64 + fr, fq * 8), boff = lds_byte(wc * 32 + fr, fq * 8);
#define PG8_SA(b, h) (((b) * 2 + (h)) * HTB)
#define PG8_SB(b, h) ((4 + (b) * 2 + (h)) * HTB)
#define PG8_STAGE(bufoff, gbase, voff) do { _Pragma("unroll") for (int _i = 0; _i < 2; ++_i) \
        __builtin_amdgcn_global_load_lds((const unsigned*)((const char*)(gbase) + (voff)[_i]), (PG8_LAS unsigned*)(lds + (bufoff) + ldsw + _i * 8192), 16, 0, 0); } while (0)
#define PG8_LDA(dst, b, h) do { _Pragma("unroll") for (int m = 0; m < 4; ++m) _Pragma("unroll") for (int k = 0; k < 2; ++k) dst[m][k] = *(const PG8_LAS bf16x8*)(lds + PG8_SA(b, h) + aoff + m * 2048 + k * 1024); } while (0)
#define PG8_LDB(dst, b, h) do { _Pragma("unroll") for (int n = 0; n < 2; ++n) _Pragma("unroll") for (int k = 0; k < 2; ++k) dst[n][k] = *(const PG8_LAS bf16x8*)(lds + PG8_SB(b, h) + boff + n * 2048 + k * 1024); } while (0)
#define PG8_MMA(ai, bj, At, Bt) do { __builtin_amdgcn_s_setprio(1); _Pragma("unroll") for (int m = 0; m < 4; ++m) _Pragma("unroll") for (int n = 0; n < 2; ++n) _Pragma("unroll") for (int k = 0; k < 2; ++k) \
        acc[ai][bj][m][n] = __builtin_amdgcn_mfma_f32_16x16x32_bf16(Bt[n][k], At[m][k], acc[ai][bj][m][n], 0, 0, 0); __builtin_amdgcn_s_setprio(0); } while (0)
#define PG8_WAIT_V(n) asm volatile("s_waitcnt vmcnt(" #n ")" ::: "memory")
#define PG8_WAIT_L(n) asm volatile("s_waitcnt lgkmcnt(" #n ")" ::: "memory")
#define PG8_BAR __builtin_amdgcn_s_barrier()
#define PG8_SCHED __builtin_amdgcn_sched_barrier(0)
    Unit cur, nxt; int ui = 0;
    if (!S.next(0, cur)) return;
    f32x4 acc[2][2][4][2];
#pragma unroll
    for (int a = 0; a < 2; ++a)
#pragma unroll
        for (int b = 0; b < 2; ++b)
#pragma unroll
            for (int m = 0; m < 4; ++m)
#pragma unroll
                for (int n = 0; n < 2; ++n) acc[a][b][m][n] = (f32x4){0.f, 0.f, 0.f, 0.f};
    if constexpr (Epi::INIT_ACC) E.init(acc, cur, wr, wc, fr, fq);
    bf16x8 At[4][2], B0[2][2], B1[2][2];
    const char* cA = (const char*)g.A + (size_t)cur.pm * tstepA; const char* cB = (const char*)g.Bt + (size_t)cur.pn * tstepB;
    S.a_ready(cur);
    if constexpr (SP2) {
        PG8_STAGE(PG8_SB(0, 0), cB, voffB); PG8_STAGE(PG8_SB(0, 1), cB + hstepB, voffB); PG8_STAGE(PG8_SA(0, 0), cA, voffA); PG8_STAGE(PG8_SA(0, 1), cA + hstepA, voffA);
        if (wr == 1) PG8_BAR;
        PG8_WAIT_V(2); PG8_BAR;
        PG8_STAGE(PG8_SB(1, 0), cB + kstep, voffB); PG8_STAGE(PG8_SA(1, 0), cA + kstep, voffA); PG8_STAGE(PG8_SB(1, 1), cB + hstepB + kstep, voffB);
        PG8_WAIT_V(6); PG8_BAR;
    } else {
        PG8_STAGE(PG8_SB(0, 0), cB, voffB); PG8_STAGE(PG8_SA(0, 0), cA, voffA); PG8_STAGE(PG8_SB(0, 1), cB + hstepB, voffB); PG8_STAGE(PG8_SA(0, 1), cA + hstepA, voffA);
        if (wr == 1) PG8_BAR;
        PG8_WAIT_V(4); PG8_BAR;
        PG8_STAGE(PG8_SB(1, 0), cB + kstep, voffB); PG8_STAGE(PG8_SA(1, 0), cA + kstep, voffA); PG8_STAGE(PG8_SB(1, 1), cB + hstepB + kstep, voffB);
        PG8_WAIT_V(6); PG8_BAR;
    }
    for (;;) {
        const bool has_next = S.next(ui + 1, nxt);
        const char* nA = has_next ? (const char*)g.A + (size_t)nxt.pm * tstepA : cA; const char* nB = has_next ? (const char*)g.Bt + (size_t)nxt.pn * tstepB : cB;
        const char* cA2 = (const char*)g.A2 + (size_t)cur.pm * tstepA; const char* cB2 = (const char*)g.Bt2 + (size_t)cur.pn * tstepB;
        const int tsplit = (Epi::HAS_MID && ks) ? ks : nt;
        for (int seg = 0, t0 = 0; t0 < nt; ++seg) { const int t1 = (seg == 0) ? tsplit : nt;
        if constexpr (Epi::HAS_MID) { if (seg) E.mid(acc, cur, wr, wc, fr, fq); }
        for (int t = t0; t < t1; t += 2) {
            const bool last = (t == nt - 2);
            const bool s1 = ks && (t + 1 >= ks), s2 = ks && (t + 2 >= ks);
            const char* a1 = s1 ? cA2 + (size_t)(t + 1 - ks) * kstep : cA + (size_t)(t + 1) * kstep;
            const char* a2 = last ? nA : (s2 ? cA2 + (size_t)(t + 2 - ks) * kstep : cA + (size_t)(t + 2) * kstep); const char* b2 = last ? nB : (s2 ? cB2 + (size_t)(t + 2 - ks) * kstep : cB + (size_t)(t + 2) * kstep);
            const char* a3 = a2 + kstep; const char* b3 = b2 + kstep;
            if (last && has_next) S.a_ready(nxt);
            if constexpr (SP2) {
            PG8_LDB(B0, 0, 0); PG8_LDB(B1, 0, 1); PG8_SCHED; PG8_LDA(At, 0, 0); PG8_STAGE(PG8_SA(1, 1), a1 + hstepA, voffA);
            PG8_WAIT_V(8); PG8_WAIT_L(0); PG8_BAR; PG8_MMA(0, 0, At, B0); PG8_MMA(0, 1, At, B1); PG8_BAR; PG8_SCHED;
            PG8_LDA(At, 0, 1); PG8_STAGE(PG8_SB(0, 0), b2, voffB); PG8_STAGE(PG8_SB(0, 1), b2 + hstepB, voffB); PG8_STAGE(PG8_SA(0, 0), a2, voffA);
            PG8_WAIT_V(8); PG8_WAIT_L(0); PG8_BAR; PG8_MMA(1, 0, At, B0); PG8_MMA(1, 1, At, B1); PG8_BAR; PG8_SCHED;
            PG8_LDB(B0, 1, 0); PG8_LDB(B1, 1, 1); PG8_SCHED; PG8_LDA(At, 1, 0); PG8_STAGE(PG8_SA(0, 1), a2 + hstepA, voffA);
            PG8_WAIT_V(8); PG8_WAIT_L(0); PG8_BAR; PG8_MMA(0, 0, At, B0); PG8_MMA(0, 1, At, B1); PG8_BAR; PG8_SCHED;
            PG8_LDA(At, 1, 1); PG8_STAGE(PG8_SB(1, 0), b3, voffB); PG8_STAGE(PG8_SB(1, 1), b3 + hstepB, voffB); PG8_STAGE(PG8_SA(1, 0), a3, voffA);
            PG8_WAIT_V(8); PG8_WAIT_L(0); PG8_BAR; PG8_MMA(1, 0, At, B0); PG8_MMA(1, 1, At, B1); PG8_BAR; PG8_SCHED;
            } else {
            PG8_LDB(B0, 0, 0); PG8_SCHED; PG8_LDA(At, 0, 0); PG8_STAGE(PG8_SA(1, 1), a1 + hstepA, voffA);
            PG8_WAIT_L(8); PG8_BAR; PG8_WAIT_L(0); PG8_MMA(0, 0, At, B0); PG8_BAR; PG8_SCHED;
            PG8_LDB(B1, 0, 1); PG8_STAGE(PG8_SB(0, 0), b2, voffB);
            PG8_BAR; PG8_WAIT_L(0); PG8_MMA(0, 1, At, B1); PG8_BAR;
            PG8_LDA(At, 0, 1); PG8_STAGE(PG8_SA(0, 0), a2, voffA);
            PG8_BAR; PG8_WAIT_L(0); PG8_MMA(1, 0, At, B0); PG8_BAR; PG8_SCHED;
            PG8_STAGE(PG8_SB(0, 1), b2 + hstepB, voffB);
            PG8_WAIT_V(6); PG8_BAR; PG8_MMA(1, 1, At, B1); PG8_BAR;
            PG8_LDB(B0, 1, 0); PG8_SCHED; PG8_LDA(At, 1, 0); PG8_STAGE(PG8_SA(0, 1), a2 + hstepA, voffA);
            PG8_WAIT_L(8); PG8_BAR; PG8_WAIT_L(0); PG8_MMA(0, 0, At, B0); PG8_BAR; PG8_SCHED;
            PG8_LDB(B1, 1, 1); PG8_STAGE(PG8_SB(1, 0), b3, voffB);
            PG8_BAR; PG8_WAIT_L(0); PG8_MMA(0, 1, At, B1); PG8_BAR;
            PG8_LDA(At, 1, 1); PG8_STAGE(PG8_SA(1, 0), a3, voffA);
            PG8_BAR; PG8_WAIT_L(0); PG8_MMA(1, 0, At, B0); PG8_BAR; PG8_SCHED;
            PG8_STAGE(PG8_SB(1, 1), b3 + hstepB, voffB);
            PG8_WAIT_V(6); PG8_BAR; PG8_MMA(1, 1, At, B1); PG8_BAR;
            }
        }
        t0 = t1; }
        if constexpr (ALIGN_EPI) { if (wr == 0) PG8_BAR; }
        if constexpr (!Epi::AFTER_DRAIN) { E(acc, cur, wr, wc, fr, fq); S.done(cur); }
        if (!has_next) break;
#pragma unroll
        for (int a = 0; a < 2; ++a)
#pragma unroll
            for (int b = 0; b < 2; ++b)
#pragma unroll
                for (int m = 0; m < 4; ++m)
#pragma unroll
                    for (int n = 0; n < 2; ++n) acc[a][b][m][n] = (f32x4){0.f, 0.f, 0.f, 0.f};
        if constexpr (Epi::INIT_ACC) E.init(acc, nxt, wr, wc, fr, fq);
        cur = nxt; cA = nA; cB = nB; ++ui;
        if constexpr (ALIGN_EPI) { if (wr == 1) PG8_BAR; }
    }
    PG8_WAIT_V(0);
    if constexpr (!ALIGN_EPI) { if (wr == 0) PG8_BAR; }
    PG8_BAR;
    if constexpr (Epi::AFTER_DRAIN) { E.fused(acc, cur, wr, wc, fr, fq, lds, wid, lane); S.done(cur); }
#undef PG8_SA
#undef PG8_SB
#undef PG8_STAGE
#undef PG8_LDA
#undef PG8_LDB
#undef PG8_MMA
#undef PG8_WAIT_V
#undef PG8_WAIT_L
#undef PG8_BAR
#undef PG8_SCHED
}
}
#define LAS __attribute__((address_space(3)))
#define RLX_AGENT __ATOMIC_RELAXED, __HIP_MEMORY_SCOPE_AGENT
#define XB_TMO      128
#define XB_XCNT(j)  (256  + 64 * (j))
#define XB_XSUB(j)  (1280 + 64 * (j))
#define XB_XGEN(j)  (2304 + 64 * (j))
#define XB_TOP      3328
#define XB_TOPGEN   3392
#define XCD_BAR_WORDS 3456
#define XB_SPIN_CAP (1u << 18)

__device__ __forceinline__ unsigned xb_ld(unsigned* p)              { return __hip_atomic_load(p, __ATOMIC_RELAXED, __HIP_MEMORY_SCOPE_AGENT); }
__device__ __forceinline__ unsigned xb_add(unsigned* p, unsigned v) { return __hip_atomic_fetch_add(p, v, __ATOMIC_RELAXED, __HIP_MEMORY_SCOPE_AGENT); }
__device__ __forceinline__ unsigned xb_xcc_id() { return (unsigned)__builtin_amdgcn_s_getreg((3 << 11) | 20) & 0xFu; }
#define XB_SPIN(cond, bar) do { unsigned _sp = 0; while (cond) { __builtin_amdgcn_s_sleep(1); \
    if ((++_sp & 255u) == 0u) { if (xb_ld(&(bar)[XB_TMO])) break; if (_sp > XB_SPIN_CAP) { atomicAdd(&(bar)[XB_TMO], 1u); break; } } } } while (0)

struct XcdBarrier {
    unsigned* bar; unsigned x;
    volatile LAS unsigned* st;
};

__device__ __forceinline__ XcdBarrier xcd_barrier_post(unsigned* bar, volatile LAS unsigned* st) {
    XcdBarrier b; b.bar = bar; b.x = xb_xcc_id(); b.st = st;
    if (threadIdx.x == 0) { const unsigned rank = xb_add(&bar[XB_XCNT(b.x)], 1u); st[2] = rank; st[3] = b.x; }
    return b;
}
__device__ __forceinline__ void xcd_barrier_complete(unsigned* bar, unsigned x, unsigned& nloc, unsigned& nx) {
    const unsigned G = gridDim.x * gridDim.y * gridDim.z;
    unsigned sum, cnt, mine, sp = 0u;
    for (;;) {
        sum = 0u; cnt = 0u; mine = 0u;
#pragma unroll
        for (unsigned j = 0; j < 16; ++j) { const unsigned c = xb_ld(&bar[XB_XCNT(j)]); sum += c; cnt += (c > 0u) ? 1u : 0u; mine = (j == x) ? c : mine; }
        if (sum == G) break;
        __builtin_amdgcn_s_sleep(1);
        if ((++sp & 255u) == 0u) { if (xb_ld(&bar[XB_TMO])) break; if (sp > XB_SPIN_CAP) { atomicAdd(&bar[XB_TMO], 1u); break; } }
    }
    nloc = mine > 0u ? mine : 1u; nx = cnt > 0u ? cnt : 1u;
}

__device__ __forceinline__ void xcd_barrier(const XcdBarrier& b) {
    asm volatile("s_waitcnt vmcnt(0)" ::: "memory");
    __syncthreads();
    if (threadIdx.x == 0) {
        unsigned* bar = b.bar;
        __builtin_amdgcn_s_waitcnt(0);
        unsigned nloc = b.st[0], nx = b.st[1];
        if (nloc == 0u) { xcd_barrier_complete(bar, b.x, nloc, nx); b.st[0] = nloc; b.st[1] = nx; }
        const unsigned old = xb_add(&bar[XB_XSUB(b.x)], 1u);
        const unsigned gen = old / nloc;
        if (old + 1u == (gen + 1u) * nloc) {
            __builtin_amdgcn_fence(__ATOMIC_RELEASE, "agent");
            asm volatile("s_waitcnt vmcnt(0)" ::: "memory");
            const unsigned og = xb_add(&bar[XB_TOP], 1u);
            const unsigned tg = og / nx;
            if (og + 1u == (tg + 1u) * nx) xb_add(&bar[XB_TOPGEN], 1u);
            else XB_SPIN(xb_ld(&bar[XB_TOPGEN]) == tg, bar);
            __builtin_amdgcn_fence(__ATOMIC_ACQUIRE, "agent");
            xb_add(&bar[XB_XGEN(b.x)], 1u);
            asm volatile("s_waitcnt vmcnt(0)" ::: "memory");
        } else {
            XB_SPIN(xb_ld(&bar[XB_XGEN(b.x)]) == gen, bar);
            __builtin_amdgcn_fence(__ATOMIC_ACQUIRE, "agent");
            asm volatile("s_waitcnt vmcnt(0)" ::: "memory");
        }
    }
    __syncthreads();
}
#undef LAS

#ifndef GATE2048
#define GATE2048 0
#endif
#define LAS __attribute__((address_space(3)))
typedef unsigned short bf16;
typedef float f32x4 __attribute__((ext_vector_type(4)));
typedef unsigned u32x4 __attribute__((ext_vector_type(4)));
typedef unsigned u32x2 __attribute__((ext_vector_type(2)));
typedef short bf16x8 __attribute__((ext_vector_type(8)));
constexpr int NWAVES = 8, NTHREADS = 512;
constexpr int LDS_BYTES = 147456;
constexpr int MISC_OFF = 131072;
constexpr size_t MiB = 1u << 20;
constexpr size_t WS_CTL = 0, CTL_BYTES = 1 * MiB;
constexpr size_t WS_PS = 1 * MiB, WS_PSV = 2 * MiB;
constexpr size_t WS_XB = 4 * MiB;
constexpr size_t WS_ACT = 36 * MiB;
constexpr size_t A_H = 0;
constexpr size_t A_U = 0, A_V = 32 * MiB, A_T = 64 * MiB, A_GB = 96 * MiB, A_SA = 128 * MiB, A_SB = 160 * MiB;
constexpr size_t WS_W = 228 * MiB;
constexpr size_t E_FIN = (size_t)2 * FF * D, E_FOUT = (size_t)D * FF, E_WIN = (size_t)NIN * D, E_SQ = (size_t)D * D;
constexpr size_t O_F1I = 0, O_F1O = O_F1I + E_FIN, O_WIN = O_F1O + E_FOUT, O_PA = O_WIN + E_WIN, O_PB = O_PA + E_SQ, O_WO = O_PB + E_SQ, O_F2I = O_WO + (GATE2048 ? 2 : 1) * E_SQ, O_F2O = O_F2I + E_FIN, E_LAYER = O_F2O + E_FOUT;
constexpr size_t WS_XL = WS_W + (size_t)DEPTH * E_LAYER * 2;
constexpr size_t WS_END = WS_XL + (size_t)M * D * 2;
static_assert(E_LAYER * 2 == (GATE2048 ? 55 : 53) * MiB, "layer weight bytes");
static_assert((size_t)M * FF * 2 <= 192 * MiB, "H fits");

__device__ __forceinline__ float wave_sum(float v) {
#pragma unroll
    for (int o = 1; o < 64; o <<= 1) v += __shfl_xor(v, o);
    return v;
}
#define LDS_WAIT() asm volatile("s_waitcnt lgkmcnt(0)" ::: "memory")

__device__ __forceinline__ int colmap(int mode, int n) {
    if (mode == 1) { const int pn = n >> 8, half = (n >> 7) & 1, jj = n & 127; return half * FF + pn * 128 + jj; }
    if (mode == 2) { if (n < 3072 || n >= 5120) return n; const int r = n - 3072, q = r >> 8, half = (r >> 7) & 1, jj = r & 127; return 3072 + half * 1024 + q * 128 + jj; }
    return n;
}
__device__ __forceinline__ void transpose_item(const float* W, int K, int Nsrc, int Ndst, int mode, const float* scale, bf16* WT, LAS unsigned* scr, int item, int lane, int ldk = 0) {
    if (ldk == 0) ldk = K;
    const int nblk = Ndst / 64, kb = item / nblk, nb = item % nblk, k0 = 64 * kb, n0 = 64 * nb, s0 = colmap(mode, n0);
    const int r = lane >> 4, c = lane & 15;
    f32x4 v[8][2];
#pragma unroll
    for (int jj = 0; jj < 8; ++jj) { const float* p = W + (size_t)(k0 + 2 * (4 * jj + r)) * Nsrc + s0 + 4 * c; v[jj][0] = *(const f32x4*)p; v[jj][1] = *(const f32x4*)(p + Nsrc); }
#pragma unroll
    for (int jj = 0; jj < 8; ++jj) { const int j = 4 * jj + r; float sa = 1.f, sb = 1.f; if (scale) { sa = scale[k0 + 2 * j]; sb = scale[k0 + 2 * j + 1]; }
        u32x4 w; w.x = pg8::cvt_pk_bf16(v[jj][0][0] * sa, v[jj][1][0] * sb); w.y = pg8::cvt_pk_bf16(v[jj][0][1] * sa, v[jj][1][1] * sb); w.z = pg8::cvt_pk_bf16(v[jj][0][2] * sa, v[jj][1][2] * sb); w.w = pg8::cvt_pk_bf16(v[jj][0][3] * sa, v[jj][1][3] * sb);
        *(LAS u32x4*)(scr + j * 68 + 4 * c) = w; }
    LDS_WAIT(); asm volatile("" ::: "memory");
    const int cc = lane & 7;
#pragma unroll
    for (int jj = 0; jj < 8; ++jj) { const int n = (lane >> 3) + 8 * jj; const LAS unsigned* s = scr + (4 * cc) * 68 + n;
        u32x4 o; o.x = s[0]; o.y = s[68]; o.z = s[136]; o.w = s[204];
        *(u32x4*)(WT + (size_t)(n0 + n) * ldk + k0 + 8 * cc) = o; }
    LDS_WAIT(); asm volatile("" ::: "memory");
}

struct Args { const float* in[17]; float* out; unsigned char* ws; int ph_lo, ph_hi; };
enum { I_X = 0, I_F1N, I_F1I, I_F1O, I_MN, I_WIN, I_SGN, I_SGW, I_SGB, I_CW, I_PA, I_PB, I_WO, I_F2N, I_F2I, I_F2O, I_FN };

__device__ __forceinline__ void convert_layer(const __attribute__((address_space(4))) Args* ap, LAS unsigned char* lds, int l, int lo, int hi, int widx, int nw, int wave, int lane) {
    LAS unsigned* scr = (LAS unsigned*)(lds + wave * 16384);
    bf16* wl = (bf16*)(ap->ws + WS_W) + (size_t)l * E_LAYER;
    constexpr int IT_FIN = (D / 64) * (2 * FF / 64), IT_FOUT = (FF / 64) * (D / 64), IT_WIN = (D / 64) * (NIN / 64), IT_SQ = (D / 64) * (D / 64);
    for (int g = lo + widx; g < hi; g += nw) {
        int r = g;
        if (r < IT_FIN) { transpose_item(ap->in[I_F1I] + (size_t)l * D * 2 * FF, D, 2 * FF, 2 * FF, 1, ap->in[I_F1N] + l * D, wl + O_F1I, scr, r, lane); continue; } r -= IT_FIN;
        if (r < IT_FOUT) { transpose_item(ap->in[I_F1O] + (size_t)l * FF * D, FF, D, D, 0, nullptr, wl + O_F1O, scr, r, lane); continue; } r -= IT_FOUT;
        if (r < IT_WIN) { transpose_item(ap->in[I_WIN] + (size_t)l * D * NIN, D, NIN, NIN, 2, ap->in[I_MN] + l * D, wl + O_WIN, scr, r, lane); continue; } r -= IT_WIN;
        if (r < IT_SQ) { transpose_item(ap->in[I_PA] + (size_t)l * D * D, D, D, D, 0, nullptr, wl + O_PA, scr, r, lane); continue; } r -= IT_SQ;
        if (r < IT_SQ) { transpose_item(ap->in[I_PB] + (size_t)l * D * D, D, D, D, 0, nullptr, wl + O_PB, scr, r, lane); continue; } r -= IT_SQ;
#if GATE2048
        if (r < IT_SQ) { transpose_item(ap->in[I_WO] + (size_t)l * D * D, D, D, D, 0, nullptr, wl + O_WO, scr, r, lane, 2 * D); continue; } r -= IT_SQ;
        if (r < IT_SQ) { transpose_item(ap->in[I_WO] + (size_t)l * D * D, D, D, D, 0, nullptr, wl + O_WO + D, scr, r, lane, 2 * D); continue; } r -= IT_SQ;
#else
        if (r < IT_SQ) { transpose_item(ap->in[I_WO] + (size_t)l * D * D, D, D, D, 0, nullptr, wl + O_WO, scr, r, lane); continue; } r -= IT_SQ;
#endif
        if (r < IT_FIN) { transpose_item(ap->in[I_F2I] + (size_t)l * D * 2 * FF, D, 2 * FF, 2 * FF, 1, ap->in[I_F2N] + l * D, wl + O_F2I, scr, r, lane); continue; } r -= IT_FIN;
        transpose_item(ap->in[I_F2O] + (size_t)l * FF * D, FF, D, D, 0, nullptr, wl + O_F2O, scr, r, lane);
    }
}
constexpr int IT_LAYER = 2 * ((D / 64) * (2 * FF / 64)) + 2 * ((FF / 64) * (D / 64)) + (D / 64) * (NIN / 64) + (GATE2048 ? 4 : 3) * ((D / 64) * (D / 64));
__device__ __forceinline__ void prologue(const __attribute__((address_space(4))) Args* ap, LAS unsigned char* lds, int gw, int NGW, int wave, int lane) {
    convert_layer(ap, lds, 0, 0, IT_LAYER / 2, gw, NGW, wave, lane);
    const float* x = ap->in[I_X]; bf16* XB = (bf16*)(ap->ws + WS_XB); bf16* XL = (bf16*)(ap->ws + WS_XL); float* PS = (float*)(ap->ws + WS_PS);
    for (int m0 = gw * 4; m0 < M; m0 += NGW * 4) {
        f32x4 v[4][4]; float s[4];
#pragma unroll
        for (int q = 0; q < 4; ++q)
#pragma unroll
            for (int j = 0; j < 4; ++j) v[q][j] = ((const f32x4*)(x + (size_t)(m0 + q) * D) + lane)[64 * j];
#pragma unroll
        for (int q = 0; q < 4; ++q) { float t = 0.f;
#pragma unroll
            for (int j = 0; j < 4; ++j) t += pg8::dot4(v[q][j]);
            s[q] = wave_sum(t); }
        asm volatile("" : "+v"(s[0]), "+v"(s[1]), "+v"(s[2]), "+v"(s[3]) :: "memory");
#pragma unroll
        for (int q = 0; q < 4; ++q) { u32x2* o8 = (u32x2*)(XB + (size_t)(m0 + q) * D) + lane; u32x2* l8 = (u32x2*)(XL + (size_t)(m0 + q) * D) + lane;
#pragma unroll
            for (int j = 0; j < 4; ++j) { u32x2 w; w.x = pg8::cvt_pk_bf16(v[q][j][0], v[q][j][1]); w.y = pg8::cvt_pk_bf16(v[q][j][2], v[q][j][3]); o8[64 * j] = w;
                const f32x4 hf = (f32x4){pg8::bflo(w.x), pg8::bfhi(w.x), pg8::bflo(w.y), pg8::bfhi(w.y)}, d = v[q][j] - hf; u32x2 wl2; wl2.x = pg8::cvt_pk_bf16(d[0], d[1]); wl2.y = pg8::cvt_pk_bf16(d[2], d[3]); if (USE_XL) l8[64 * j] = wl2; }
            if (lane < 16) PS[(size_t)(m0 + q) * 16 + lane] = lane == 0 ? s[q] : 0.f; }
    }
}

struct SguLoads { u32x4 v[4]; f32x4 ps[4]; u32x2 u[4][2]; };
__device__ __forceinline__ void sgu_issue(SguLoads& L, int c, int h, const bf16* U, const bf16* V, const float* PSV, int tid) {
    const int R0 = c * CHUNK, C0 = h * 128, p = tid & 127, dq = tid >> 7;
    const int lane = tid & 63, wid = tid >> 6, wr = wid >> 2, wc = wid & 3, fr = lane & 15, fq = lane >> 4;
#pragma unroll
    for (int i = 0; i < 4; ++i) L.v[i] = *(const u32x4*)(V + (size_t)(R0 + p) * D + C0 + (dq + 4 * i) * 8);
#pragma unroll
    for (int i = 0; i < 4; ++i) L.ps[i] = *(const f32x4*)(PSV + (size_t)(R0 + p) * 16 + 4 * i);
#pragma unroll
    for (int m = 0; m < 4; ++m)
#pragma unroll
        for (int n = 0; n < 2; ++n) L.u[m][n] = *(const u32x2*)(U + (size_t)(R0 + wr * 64 + m * 16 + fr) * D + C0 + wc * 32 + n * 16 + 4 * fq);
}
__device__ __forceinline__ void sgu_phase(LAS unsigned char* lds, int bx, int G, const bf16* U, bf16* UO, const bf16* V, const float* PSV, const float* sgw_l, const float* sgb_l, const float* sgn_l, int tid) {
    LAS bf16* As = (LAS bf16*)lds;
    LAS bf16* Vt = (LAS bf16*)(lds + 34816);
    const int NT = (M / CHUNK) * HEADS;
    if (bx >= NT) return;
    const int h = bx & 7;
    const float* wsh = sgw_l + (size_t)h * CHUNK * CHUNK; const float* bsh = sgb_l + h * CHUNK; const float* gn = sgn_l + h * 128;
    const int lane = tid & 63, wid = tid >> 6, wr = wid >> 2, wc = wid & 3, fr = lane & 15, fq = lane >> 4;
    SguLoads L; sgu_issue(L, bx >> 3, h, U, V, PSV, tid);
#pragma unroll
    for (int i = 0; i < 4; ++i) { const int it = tid + i * NTHREADS, q = it >> 4, p8 = (it & 15) * 8; const float* src = wsh + q * 128 + p8;
        *(LAS u32x4*)(As + q * 136 + p8) = pg8::pack8(*(const f32x4*)src, *(const f32x4*)(src + 4)); }
    f32x4 gv[2]; float bq[4];
#pragma unroll
    for (int n = 0; n < 2; ++n) gv[n] = *(const f32x4*)(gn + wc * 32 + n * 16 + 4 * fq);
#pragma unroll
    for (int m = 0; m < 4; ++m) bq[m] = bsh[wr * 64 + m * 16 + fr];
    for (int t = bx; t < NT; t += G) {
        const int c = t >> 3, R0 = c * CHUNK, C0 = h * 128, p = tid & 127, dq = tid >> 7;
        const float rsp = rsqrtf(((pg8::sum4(L.ps[0]) + pg8::sum4(L.ps[1])) + (pg8::sum4(L.ps[2]) + pg8::sum4(L.ps[3]))) * (1.0f / 1024.0f) + EPS);
#pragma unroll
        for (int i = 0; i < 4; ++i) { f32x4 a, b; pg8::unpack8(L.v[i], a, b); const u32x4 w = pg8::pack8(a * rsp, b * rsp); LAS bf16* dst = Vt + (dq + 4 * i) * 8 * 136 + p;
            dst[0 * 136] = (bf16)(w.x & 0xffffu); dst[1 * 136] = (bf16)(w.x >> 16); dst[2 * 136] = (bf16)(w.y & 0xffffu); dst[3 * 136] = (bf16)(w.y >> 16);
            dst[4 * 136] = (bf16)(w.z & 0xffffu); dst[5 * 136] = (bf16)(w.z >> 16); dst[6 * 136] = (bf16)(w.w & 0xffffu); dst[7 * 136] = (bf16)(w.w >> 16); }
        u32x2 uc[4][2];
#pragma unroll
        for (int m = 0; m < 4; ++m)
#pragma unroll
            for (int n = 0; n < 2; ++n) uc[m][n] = L.u[m][n];
        asm volatile("" : "+v"(uc[0][0]), "+v"(uc[0][1]), "+v"(uc[1][0]), "+v"(uc[1][1]), "+v"(uc[2][0]), "+v"(uc[2][1]), "+v"(uc[3][0]), "+v"(uc[3][1]) :: "memory");
        if (t + G < NT) sgu_issue(L, (t + G) >> 3, h, U, V, PSV, tid);
        __syncthreads();
        f32x4 acc[4][2];
#pragma unroll
        for (int m = 0; m < 4; ++m)
#pragma unroll
            for (int n = 0; n < 2; ++n) acc[m][n] = (f32x4){0.f, 0.f, 0.f, 0.f};
#pragma unroll
        for (int kk = 0; kk < 4; ++kk) { bf16x8 af[4], bf[2];
#pragma unroll
            for (int m = 0; m < 4; ++m) af[m] = *(const LAS bf16x8*)(As + (wr * 64 + m * 16 + fr) * 136 + kk * 32 + fq * 8);
#pragma unroll
            for (int n = 0; n < 2; ++n) bf[n] = *(const LAS bf16x8*)(Vt + (wc * 32 + n * 16 + fr) * 136 + kk * 32 + fq * 8);
#pragma unroll
            for (int m = 0; m < 4; ++m)
#pragma unroll
                for (int n = 0; n < 2; ++n) acc[m][n] = __builtin_amdgcn_mfma_f32_16x16x32_bf16(bf[n], af[m], acc[m][n], 0, 0, 0); }
#pragma unroll
        for (int m = 0; m < 4; ++m)
#pragma unroll
            for (int n = 0; n < 2; ++n) { bf16* uo = UO + (size_t)(R0 + wr * 64 + m * 16 + fr) * D + C0 + wc * 32 + n * 16 + 4 * fq;
                const f32x4 uu = (f32x4){pg8::bflo(uc[m][n].x), pg8::bfhi(uc[m][n].x), pg8::bflo(uc[m][n].y), pg8::bfhi(uc[m][n].y)};
                const f32x4 o = uu * (gv[n] * acc[m][n] + bq[m]);
                u32x2 w; w.x = pg8::cvt_pk_bf16(o[0], o[1]); w.y = pg8::cvt_pk_bf16(o[2], o[3]); *(u32x2*)uo = w; }
        __syncthreads();
    }
}

__device__ __forceinline__ void conv_phase(const bf16* GB, bf16* GBO, const bf16* T, const float* cw, int gtid, int nthr) {
    constexpr int RPS = 16;
    for (int it = gtid; it < (M / RPS) * (D / 8); it += nthr) { const int c8 = (it & 127) * 8, r0 = (it >> 7) * RPS;
        const f32x4 w00 = *(const f32x4*)(cw + c8), w01 = *(const f32x4*)(cw + c8 + 4), w10 = *(const f32x4*)(cw + D + c8), w11 = *(const f32x4*)(cw + D + c8 + 4), w20 = *(const f32x4*)(cw + 2 * D + c8), w21 = *(const f32x4*)(cw + 2 * D + c8 + 4);
#pragma unroll
        for (int hb = 0; hb < 2; ++hb) { const int rb = r0 + 8 * hb; const size_t off = (size_t)rb * D + c8;
            u32x4 t[10], g[8]; const u32x4 z = (u32x4){0u, 0u, 0u, 0u};
            t[0] = ((rb & (SEQ - 1)) > 0) ? *(const u32x4*)(T + off - D) : z;
#pragma unroll
            for (int j = 0; j < 8; ++j) { t[j + 1] = *(const u32x4*)(T + off + (size_t)j * D); g[j] = *(const u32x4*)(GB + off + (size_t)j * D); }
            t[9] = (((rb + 7) & (SEQ - 1)) < SEQ - 1) ? *(const u32x4*)(T + off + (size_t)8 * D) : z;
            u32x4 o[8];
#pragma unroll
            for (int j = 0; j < 8; ++j) { f32x4 a0, a1, b0, b1, c0, c1, g0, g1; pg8::unpack8(t[j], a0, a1); pg8::unpack8(t[j + 1], b0, b1); pg8::unpack8(t[j + 2], c0, c1); pg8::unpack8(g[j], g0, g1);
                o[j] = pg8::pack8(g0 * (w00 * a0 + w10 * b0 + w20 * c0), g1 * (w01 * a1 + w11 * b1 + w21 * c1)); }
            asm volatile("" : "+v"(o[0]), "+v"(o[1]), "+v"(o[2]), "+v"(o[3]), "+v"(o[4]), "+v"(o[5]), "+v"(o[6]), "+v"(o[7]) :: "memory");
#pragma unroll
            for (int j = 0; j < 8; ++j) *(u32x4*)(GBO + off + (size_t)j * D) = o[j];
        } }
}

__device__ __forceinline__ void final_phase(float* out, const bf16* XH, const bf16* XL, const float* g, int gw, int NGW, int lane) {
    f32x4 gv[4];
#pragma unroll
    for (int j = 0; j < 4; ++j) gv[j] = ((const f32x4*)g)[lane + 64 * j];
    for (int m0 = gw * 4; m0 < M; m0 += NGW * 4) { f32x4 v[4][4]; float rs[4];
#pragma unroll
        for (int q = 0; q < 4; ++q)
#pragma unroll
            for (int j = 0; j < 4; ++j) { const u32x2 h = ((const u32x2*)(XH + (size_t)(m0 + q) * D) + lane)[64 * j], lo = USE_XL ? ((const u32x2*)(XL + (size_t)(m0 + q) * D) + lane)[64 * j] : (u32x2){0u, 0u};
                v[q][j] = (f32x4){pg8::bflo(h.x) + pg8::bflo(lo.x), pg8::bfhi(h.x) + pg8::bfhi(lo.x), pg8::bflo(h.y) + pg8::bflo(lo.y), pg8::bfhi(h.y) + pg8::bfhi(lo.y)}; }
#pragma unroll
        for (int q = 0; q < 4; ++q) { float t = 0.f;
#pragma unroll
            for (int j = 0; j < 4; ++j) t += pg8::dot4(v[q][j]);
            rs[q] = rsqrtf(wave_sum(t) * (1.0f / D) + EPS); }
        asm volatile("" : "+v"(rs[0]), "+v"(rs[1]), "+v"(rs[2]), "+v"(rs[3]) :: "memory");
#pragma unroll
        for (int q = 0; q < 4; ++q)
#pragma unroll
            for (int j = 0; j < 4; ++j) ((f32x4*)(out + (size_t)(m0 + q) * D) + lane)[64 * j] = v[q][j] * rs[q] * gv[j]; }
}

__device__ __forceinline__ void final_phase_f32(float* out, const float* g, int gw, int NGW, int lane) {
    f32x4 gv[4];
#pragma unroll
    for (int j = 0; j < 4; ++j) gv[j] = ((const f32x4*)g)[lane + 64 * j];
    for (int m0 = gw * 4; m0 < M; m0 += NGW * 4) { f32x4 v[4][4]; float rs[4];
#pragma unroll
        for (int q = 0; q < 4; ++q)
#pragma unroll
            for (int j = 0; j < 4; ++j) v[q][j] = ((const f32x4*)(out + (size_t)(m0 + q) * D) + lane)[64 * j];
#pragma unroll
        for (int q = 0; q < 4; ++q) { float t = 0.f;
#pragma unroll
            for (int j = 0; j < 4; ++j) t += pg8::dot4(v[q][j]);
            rs[q] = rsqrtf(wave_sum(t) * (1.0f / D) + EPS); }
        asm volatile("" : "+v"(rs[0]), "+v"(rs[1]), "+v"(rs[2]), "+v"(rs[3]) :: "memory");
#pragma unroll
        for (int q = 0; q < 4; ++q)
#pragma unroll
            for (int j = 0; j < 4; ++j) ((f32x4*)(out + (size_t)(m0 + q) * D) + lane)[64 * j] = v[q][j] * rs[q] * gv[j]; }
}

#ifndef RESID_HILO
#define RESID_HILO 1
#endif
#ifndef PROBE_KIND
#define PROBE_KIND -1
#endif
#ifndef PROBE_SKIP_EPI
#define PROBE_SKIP_EPI 0
#endif
#ifndef EN_MASK
#define EN_MASK 63
#endif
#define EN(k) ((EN_MASK >> (k)) & 1)
constexpr int KPL = 9;
constexpr int N_PHASES = 2 + KPL * DEPTH;

constexpr int RS_OFF = MISC_OFF + 1024;
__device__ __forceinline__ void fill_rstd(LAS unsigned char* lds, const float* PS, int pm, int tid) {
    if (tid < 256) { const float* p = PS + (size_t)(pm * 256 + tid) * 16; const f32x4 a = *(const f32x4*)p, b = *(const f32x4*)(p + 4), c = *(const f32x4*)(p + 8), d = *(const f32x4*)(p + 12);
        ((LAS float*)(lds + RS_OFF))[tid] = rsqrtf(((pg8::sum4(a) + pg8::sum4(b)) + (pg8::sum4(c) + pg8::sum4(d))) * (1.0f / 1024.0f) + EPS); }
    __syncthreads();
}
typedef const __attribute__((address_space(4))) Args* KArgs;
__global__ void __launch_bounds__(NTHREADS, 2) fwd(Args a_unused) {
    extern __shared__ __attribute__((aligned(16))) unsigned char lds_raw[];
    LAS unsigned char* lds = (LAS unsigned char*)lds_raw;
    KArgs kap = (KArgs)__builtin_amdgcn_kernarg_segment_ptr();
    const int ph_lo = kap->ph_lo, ph_hi = kap->ph_hi;
#if MK_XCDBAR
    for (int u = threadIdx.x; u < (LDS_BYTES - MISC_OFF) / 4; u += NTHREADS) ((LAS unsigned*)(lds + MISC_OFF))[u] = 0u;
    __syncthreads();
    XcdBarrier bar = xcd_barrier_post((unsigned*)(kap->ws + WS_CTL) + 4096, (volatile LAS unsigned*)(lds + MISC_OFF) + 8);
#endif
    for (int ph = ph_lo; ph < ph_hi; ++ph) {
        if (ph > ph_lo && !(ph >= 1 && ph < N_PHASES - 1 && (ph - 1) % KPL == 5)) {
#if MK_XCDBAR
            if (ph_hi > 1000) cg::this_grid().sync();
            xcd_barrier(bar);
            if (ph == ph_lo + 1) {
                if (threadIdx.x == 0) { bool uni = gridDim.x == 256; for (unsigned j = 0; j < 16; ++j) { const unsigned c = xb_ld(&bar.bar[XB_XCNT(j)]); uni = uni && (c == (j < 8 ? 32u : 0u)); }
                    bar.st[4] = uni ? (bar.st[2] * 8u + bar.st[3]) : blockIdx.x; }
                __syncthreads(); }
#else
            cg::this_grid().sync();
#endif
        }
        int nrep = 1;
#if PROBE_KIND == 100
        if (ph == 0) nrep = 2;
#elif PROBE_KIND >= 0
        if (ph >= 1 && ph < N_PHASES - 1 && ((ph - 1) % KPL) == PROBE_KIND) nrep = 2;
#endif
        for (int rep = 0; rep < nrep; ++rep) {
#if MK_XCDBAR
        if (rep) xcd_barrier(bar);
#else
        if (rep) cg::this_grid().sync();
#endif
        KArgs ap = kap; asm volatile("" : "+s"(ap));
        int tid = threadIdx.x; asm volatile("" : "+v"(tid));
        const int lane = tid & 63, wave = __builtin_amdgcn_readfirstlane(tid >> 6);
        const int G = gridDim.x, bx = (MK_XCDBAR && ph > ph_lo) ? __builtin_amdgcn_readfirstlane((int)((volatile LAS unsigned*)(lds + MISC_OFF))[12]) : (int)blockIdx.x;
        const int gw = bx * NWAVES + wave, NGW = G * NWAVES;
        unsigned char* ws = ap->ws;
        bf16* XB = (bf16*)(ws + WS_XB); float* PS = (float*)(ws + WS_PS); float* PSV = (float*)(ws + WS_PSV);
        unsigned char* act = ws + WS_ACT;
        bf16* Hb = (bf16*)(act + A_H); bf16* Ub = (bf16*)(act + A_U); bf16* Vb = (bf16*)(act + A_V); bf16* Tb = (bf16*)(act + A_T); bf16* GBb = (bf16*)(act + A_GB); bf16* SAb = (bf16*)(act + A_SA); bf16* SBb = (bf16*)(act + A_SB);
        bf16* G2 = (bf16*)(act + A_V);
        bf16* XLb = (bf16*)(ws + WS_XL);
        const bf16* WB = (const bf16*)(ws + WS_W);
        if (EN(5) && ph == 0) { prologue(ap, lds, gw, NGW, wave, lane); continue; }
#if RESID_HILO
        if (ph == N_PHASES - 1) { final_phase(ap->out, XB, XLb, ap->in[I_FN], gw, NGW, lane); continue; }
#else
        if (ph == N_PHASES - 1) { final_phase_f32(ap->out, ap->in[I_FN], gw, NGW, lane); continue; }
#endif
        const int l = (ph - 1) / KPL, kind = (ph - 1) % KPL;
        const bf16* wl = WB + (size_t)l * E_LAYER;
        if (EN(0) && (kind == 0 || kind == 7)) {
            pg8::Gemm g{XB, wl + (kind == 0 ? O_F1I : O_F2I), M, 2 * FF, D}; pg8::StaticOrder S; S.init(M, 2 * FF, G, bx);
            { pg8::Unit u0; S.next(0, u0); fill_rstd(lds, PS, u0.pm, tid); }
            pg8::EpiFfnUp E{Hb, (const LAS float*)(lds + RS_OFF), PROBE_SKIP_EPI && nrep == 2 && rep == 0};
            pg8::gemm_phase<pg8::EpiFfnUp, pg8::StaticOrder, true, true>(lds, g, S, E);
            if (bx >= 128) {
                const int nw = 128 * NWAVES, wi = (bx - 128) * NWAVES + wave;
                if (kind == 0) convert_layer(ap, lds, l, IT_LAYER / 2, IT_LAYER, wi, nw, wave, lane);
                else if (l + 1 < DEPTH) convert_layer(ap, lds, l + 1, 0, IT_LAYER / 2, wi, nw, wave, lane); }
        } else if (EN(1) && (kind == 1 || kind == 8 || kind == 6)) {
            const bool ffn = kind != 6;
            pg8::Gemm g{ffn ? Hb : (GATE2048 ? G2 : SAb), wl + (kind == 1 ? O_F1O : (kind == 8 ? O_F2O : O_WO)), M, D, ffn ? FF : (GATE2048 ? 2 * D : D)}; pg8::StaticOrder S; S.init(M, D, G, bx);
#if RESID_HILO
            pg8::EpiResid E{XB, XLb, PS, ffn ? 0.5f : 1.0f, ffn ? 2.0f : 1.0f};
            pg8::gemm_phase<pg8::EpiResid, pg8::StaticOrder, true, true>(lds, g, S, E);
#else
            pg8::EpiResidF32 E{(l == 0 && kind == 1) ? ap->in[I_X] : ap->out, ap->out, XB, PS, ffn ? 0.5f : 1.0f, ffn ? 2.0f : 1.0f};
            pg8::gemm_phase<pg8::EpiResidF32, pg8::StaticOrder, true, true>(lds, g, S, E);
#endif
        } else if (EN(2) && kind == 2) {
            pg8::Gemm g{XB, wl + O_WIN, M, NIN, D}; pg8::StaticOrder S; S.init(M, NIN, G, bx);
            { pg8::Unit u0; S.next(0, u0); fill_rstd(lds, PS, u0.pm, tid); }
            pg8::EpiMixIn E{Ub, Vb, Tb, GBb, SAb, SBb, (const LAS float*)(lds + RS_OFF), PSV};
            pg8::gemm_phase<pg8::EpiMixIn, pg8::StaticOrder, true, true>(lds, g, S, E);
        } else if (EN(3) && kind == 3) {
            sgu_phase(lds, bx, G, Ub, (nrep == 2 && rep == 0) ? (bf16*)(ws + WS_END) : Ub, Vb, PSV, ap->in[I_SGW] + (size_t)l * HEADS * CHUNK * CHUNK, ap->in[I_SGB] + (size_t)l * HEADS * CHUNK, ap->in[I_SGN] + (size_t)l * D, tid);
            conv_phase(GBb, (nrep == 2 && rep == 0) ? (bf16*)(ws + WS_END) : GBb, Tb, ap->in[I_CW] + (size_t)l * 3 * D, bx * NTHREADS + tid, G * NTHREADS);
        } else if (EN(4) && kind == 4) {
            pg8::StaticOrder S; S.init(M, D, G, bx);
            pg8::Gemm g{Ub, wl + O_PA, M, D, 2 * D, GBb, wl + O_PB, D / pg8::BK, D, D}; pg8::EpiMerge E{SAb, SBb, SAb};
            pg8::gemm_phase<pg8::EpiMerge, pg8::StaticOrder, true, true>(lds, g, S, E);
        }
        }
    }
}

extern "C" void kernel_launch(void* const* d_in, const int* in_sizes, int n_in, void* d_out, int out_size, void* d_ws, size_t ws_size, hipStream_t stream) {
    static int state = 0;
    if (state == 0) {
        if (n_in != 17 || in_sizes[0] != M * D || out_size != M * D || ws_size < WS_END + (PROBE_KIND == 3 ? 32 * MiB : 0)) { fprintf(stderr, "kernel_launch: unexpected shapes (n_in %d, in0 %d, out %d, ws %zu < %zu)\n", n_in, n_in > 0 ? in_sizes[0] : -1, out_size, ws_size, (size_t)WS_END); state = -1; return; }
        if (hipFuncSetAttribute((const void*)fwd, hipFuncAttributeMaxDynamicSharedMemorySize, LDS_BYTES) != hipSuccess) { fprintf(stderr, "kernel_launch: hipFuncSetAttribute failed\n"); state = -1; return; }
        state = 1;
    }
    if (state < 0) return;
    (void)hipMemsetAsync((char*)d_ws + WS_CTL + 16384, 0, 16384, stream);
    Args a{};
    for (int i = 0; i < 17; ++i) a.in[i] = (const float*)d_in[i];
    a.out = (float*)d_out; a.ws = (unsigned char*)d_ws;
#if MK_SINGLE
    a.ph_lo = 0; a.ph_hi = N_PHASES;
    void* params[] = {&a};
    hipError_t e = hipLaunchCooperativeKernel((const void*)fwd, dim3(256), dim3(NTHREADS), params, LDS_BYTES, stream);
    if (e != hipSuccess) fprintf(stderr, "kernel_launch: cooperative launch failed: %s\n", hipGetErrorString(e));
#else
    for (int ph = 0; ph < N_PHASES; ++ph) { a.ph_lo = ph; a.ph_hi = ph + 1; hipLaunchKernelGGL(fwd, dim3(256), dim3(NTHREADS), LDS_BYTES, stream, a); }
#endif
}
```

```cpp
#include <hip/hip_runtime.h>
#include <hip/hip_cooperative_groups.h>
#include <cstdio>
#include <cstdint>
namespace cg = cooperative_groups;

#ifndef MK_SINGLE
#define MK_SINGLE 1
#endif
#ifndef MK_XCDBAR
#define MK_XCDBAR 1
#endif

constexpr int BATCH = 8, SEQ = 2048, D = 1024, DEPTH = 4, FF = 2816, NIN = 7168, CHUNK = 128, HEADS = 8;
constexpr int M = BATCH * SEQ;
constexpr float EPS = 1e-6f;
constexpr bool USE_XL = false;

namespace pg8 {
#define PG8_LAS __attribute__((address_space(3)))
typedef unsigned short bf16_t;
typedef short bf16x8 __attribute__((ext_vector_type(8)));
typedef float f32x4 __attribute__((ext_vector_type(4)));
typedef unsigned u32x4 __attribute__((ext_vector_type(4)));
constexpr int BM = 256, BK = 64, HALF = 128, HTB = HALF * BK * 2  , STAGE_BYTES = 8 * HTB, NXCD = 8, WGM = 8;

__host__ __device__ __forceinline__ int lds_byte(int r, int c) { const int st = (r >> 4) * 2 + (c >> 5), rr = r & 15, cc = c & 31, ob = rr * 64 + cc * 2; return st * 1024 + (ob ^ (((ob >> 9) & 1) << 5)); }
__host__ __device__ __forceinline__ void stage_rc(int b, int& R, int& C) { const int st = b / 1024, sb = b % 1024, swz = sb ^ (((sb >> 9) & 1) << 5); R = (st >> 1) * 16 + swz / 64; C = (st & 1) * 32 + (swz % 64) / 2; }
__host__ __device__ __forceinline__ int perm32(int rho) { const int n = rho >> 4, i = rho & 15; return 8 * (i >> 2) + 4 * n + (i & 3); }

struct Unit { int pm, pn; };
struct Gemm { const bf16_t* A; const bf16_t* Bt; int M, N, K; const bf16_t* A2; const bf16_t* Bt2; int ksplit, lda, ldb; };

struct StaticOrder {
    int nM, nN, nwg, G, c;
    __host__ __device__ void init(int M, int N, int G_, int c_) { nM = M / BM; nN = N / BM; nwg = nM * nN; G = G_; c = c_; }
    __host__ __device__ bool next(int i, Unit& u) const {
        if (nM == 64 && G == 256) {
            u.pm = 8 * (c & 7) + ((c >> 3) & 7); u.pn = 4 * i + (c >> 6); return u.pn < nN; }
        const long L = (long)i * G + c; if (L >= nwg) return false;
        int wgid = (int)L; { const int q = nwg / NXCD, r = nwg % NXCD, xcd = wgid % NXCD, off = wgid / NXCD; wgid = (xcd < r ? xcd * (q + 1) : r * (q + 1) + (xcd - r) * q) + off; }
        const int nig = WGM * nN, gid = wgid / nig, fm = gid * WGM, gsz = (nM - fm) < WGM ? (nM - fm) : WGM;
        u.pm = fm + ((wgid % nig) % gsz); u.pn = (wgid % nig) / gsz; return true;
    }
    __device__ __forceinline__ void a_ready(const Unit&) const {}
    __device__ __forceinline__ void done(const Unit&) const {}
};
typedef _Float16 h2_t __attribute__((ext_vector_type(2))); typedef _Float16 h8_t __attribute__((ext_vector_type(8)));
__device__ __forceinline__ unsigned cvt_pk_bf16(float lo, float hi) { unsigned r; asm volatile("v_cvt_pk_bf16_f32 %0, %1, %2" : "=v"(r) : "v"(lo), "v"(hi)); return r; }
typedef unsigned u32x2 __attribute__((ext_vector_type(2)));
__device__ __forceinline__ float fsigmoid(float x) { return __builtin_amdgcn_rcpf(1.0f + __builtin_amdgcn_exp2f(-1.44269504089f * x)); }
__device__ __forceinline__ float fsilu(float x) { return x * fsigmoid(x); }
__device__ __forceinline__ float fgelu(float x) { return x * fsigmoid(1.59576912161f * (x + 0.044715f * x * x * x)); }
__device__ __forceinline__ f32x4 vexp2(const f32x4 t) { return (f32x4){__builtin_amdgcn_exp2f(t[0]), __builtin_amdgcn_exp2f(t[1]), __builtin_amdgcn_exp2f(t[2]), __builtin_amdgcn_exp2f(t[3])}; }
__device__ __forceinline__ f32x4 vrcp(const f32x4 t) { return (f32x4){__builtin_amdgcn_rcpf(t[0]), __builtin_amdgcn_rcpf(t[1]), __builtin_amdgcn_rcpf(t[2]), __builtin_amdgcn_rcpf(t[3])}; }
__device__ __forceinline__ f32x4 vsig_from_t(const f32x4 t) { return vrcp(vexp2(t) + 1.0f); }
__device__ __forceinline__ f32x4 vgelu(const f32x4 x) { const f32x4 w = (x * x) * (-0.10294324f) + (-2.30220819f); return x * vsig_from_t(w * x); }
typedef __amdgpu_buffer_rsrc_t rsrc_t;
__device__ __forceinline__ rsrc_t mk_rsrc(const void* p, size_t bytes) { return __builtin_amdgcn_make_buffer_rsrc((void*)p, 0, (int)bytes, 0x00020000); }
__device__ __forceinline__ void st16_wt(const rsrc_t r, size_t byte_off, const u32x4 v) { __builtin_amdgcn_raw_buffer_store_b128(v, r, (unsigned)byte_off, 0,   16); }
__device__ __forceinline__ u32x4 ld16_b(const rsrc_t r, unsigned voff, unsigned soff) { return __builtin_amdgcn_raw_buffer_load_b128(r, voff, soff, 0); }
__device__ __forceinline__ float bflo(unsigned w) { return __uint_as_float(w << 16); }
__device__ __forceinline__ float bfhi(unsigned w) { return __uint_as_float(w & 0xffff0000u); }
__device__ __forceinline__ u32x4 pack8(const f32x4 a, const f32x4 b) { u32x4 w; w.x = cvt_pk_bf16(a[0], a[1]); w.y = cvt_pk_bf16(a[2], a[3]); w.z = cvt_pk_bf16(b[0], b[1]); w.w = cvt_pk_bf16(b[2], b[3]); return w; }
__device__ __forceinline__ void unpack8(const u32x4 w, f32x4& a, f32x4& b) { a = (f32x4){bflo(w.x), bfhi(w.x), bflo(w.y), bfhi(w.y)}; b = (f32x4){bflo(w.z), bfhi(w.z), bflo(w.w), bfhi(w.w)}; }
__device__ __forceinline__ float sum4(const f32x4 v) { return (v[0] + v[1]) + (v[2] + v[3]); }
__device__ __forceinline__ float dot4(const f32x4 v) { return (v[0] * v[0] + v[1] * v[1]) + (v[2] * v[2] + v[3] * v[3]); }
__device__ __forceinline__ float row_rstd(const float* PS, int row, int fq) {
    float s = sum4(*(const f32x4*)(PS + (size_t)row * 16 + 4 * fq)); s += __shfl_xor(s, 16); s += __shfl_xor(s, 32);
    return rsqrtf(s * (1.0f / 1024.0f) + EPS);
}

#define PIN8(a) asm volatile("" : "+v"(a[0][0]), "+v"(a[0][1]), "+v"(a[0][2]), "+v"(a[0][3]), "+v"(a[1][0]), "+v"(a[1][1]), "+v"(a[1][2]), "+v"(a[1][3]) :: "memory")
#define PIN16(a) asm volatile("" : "+v"(a[0][0][0]), "+v"(a[0][0][1]), "+v"(a[0][1][0]), "+v"(a[0][1][1]), "+v"(a[0][2][0]), "+v"(a[0][2][1]), "+v"(a[0][3][0]), "+v"(a[0][3][1]), \
                                    "+v"(a[1][0][0]), "+v"(a[1][0][1]), "+v"(a[1][1][0]), "+v"(a[1][1][1]), "+v"(a[1][2][0]), "+v"(a[1][2][1]), "+v"(a[1][3][0]), "+v"(a[1][3][1]) :: "memory")
__device__ __forceinline__ void rows_rstd(const PG8_LAS float* RS, int wr, int fr, float (&rs)[2][4]) {
#pragma unroll
    for (int ai = 0; ai < 2; ++ai)
#pragma unroll
        for (int m = 0; m < 4; ++m) rs[ai][m] = RS[wr * 64 + ai * HALF + m * 16 + fr];
}

struct EpiFfnUp {
    static constexpr bool PERM = true, AFTER_DRAIN = false, INIT_ACC = false, HAS_MID = false;
    bf16_t* H; const PG8_LAS float* RS; bool skip;
    __device__ __forceinline__ void operator()(const f32x4 (&acc)[2][2][4][2], const Unit& u, int wr, int wc, int fr, int fq) const {
        const int row0 = u.pm * BM + wr * 64 + fr, col0 = u.pn * 128 + wc * 32 + 8 * fq;
        if (skip) { if (acc[0][0][0][0][0] == 123.456f) H[row0] = 0; return; }
        float rs[2][4]; rows_rstd(RS, wr, fr, rs);
        const rsrc_t rH = mk_rsrc(H, (size_t)M * FF * 2);
#pragma unroll
        for (int ai = 0; ai < 2; ++ai)
#pragma unroll
            for (int m = 0; m < 4; ++m) { const int row = row0 + ai * HALF + m * 16; const float r = rs[ai][m];
                const float c = -1.44269504089f * r, r2 = r * r;
                const f32x4 h0 = (acc[ai][0][m][0] * acc[ai][1][m][0]) * (vsig_from_t(acc[ai][0][m][0] * c) * r2), h1 = (acc[ai][0][m][1] * acc[ai][1][m][1]) * (vsig_from_t(acc[ai][0][m][1] * c) * r2);
                st16_wt(rH, ((size_t)row * FF + col0) * 2, pack8(h0, h1)); }
    }
};
struct EpiResid {
    static constexpr bool PERM = true, AFTER_DRAIN = false, INIT_ACC = true, HAS_MID = false;
    bf16_t* XH; bf16_t* XL; float* PS; float scale, inv_scale;
    __device__ __forceinline__ void init(f32x4 (&acc)[2][2][4][2], const Unit& u, int wr, int wc, int fr, int fq) const {
        const int row0 = u.pm * BM + wr * 64 + fr, col0 = u.pn * BM + wc * 32 + 8 * fq;
#pragma unroll
        for (int ai = 0; ai < 2; ++ai)
#pragma unroll
            for (int m = 0; m < 4; ++m)
#pragma unroll
                for (int bj = 0; bj < 2; ++bj) { const size_t off = (size_t)(row0 + ai * HALF + m * 16) * D + col0 + bj * HALF;
                    f32x4 h0, h1, l0 = (f32x4){0.f, 0.f, 0.f, 0.f}, l1 = l0; unpack8(*(const u32x4*)(XH + off), h0, h1); if (USE_XL) unpack8(*(const u32x4*)(XL + off), l0, l1);
                    acc[ai][bj][m][0] = (h0 + l0) * inv_scale; acc[ai][bj][m][1] = (h1 + l1) * inv_scale; }
    }
    __device__ __forceinline__ void operator()(const f32x4 (&acc)[2][2][4][2], const Unit& u, int wr, int wc, int fr, int fq) const {
        const int row0 = u.pm * BM + wr * 64 + fr, col0 = u.pn * BM + wc * 32 + 8 * fq;
        const rsrc_t rXH = mk_rsrc(XH, (size_t)M * D * 2), rXL = mk_rsrc(XL, (size_t)M * D * 2);
#pragma unroll
        for (int ai = 0; ai < 2; ++ai)
#pragma unroll
            for (int m = 0; m < 4; ++m) { const int row = row0 + ai * HALF + m * 16; float ss = 0.f;
#pragma unroll
                for (int bj = 0; bj < 2; ++bj) { const size_t off = (size_t)row * D + col0 + bj * HALF;
                    const f32x4 a = acc[ai][bj][m][0] * scale, b = acc[ai][bj][m][1] * scale; ss += dot4(a) + dot4(b);
                    const u32x4 hi = pack8(a, b); f32x4 ha, hb; unpack8(hi, ha, hb);
                    st16_wt(rXH, off * 2, hi); if (USE_XL) st16_wt(rXL, off * 2, pack8(a - ha, b - hb)); }
                ss += __shfl_xor(ss, 16); ss += __shfl_xor(ss, 32);
                if (fq == 0) PS[(size_t)row * 16 + u.pn * 4 + wc] = ss; }
    }
};
struct EpiResidF32 {
    static constexpr bool PERM = true, AFTER_DRAIN = false, INIT_ACC = true, HAS_MID = false;
    const float* xs; float* xd; bf16_t* XB; float* PS; float scale, inv_scale;
    __device__ __forceinline__ void init(f32x4 (&acc)[2][2][4][2], const Unit& u, int wr, int wc, int fr, int fq) const {
        const int row0 = u.pm * BM + wr * 64 + fr, col0 = u.pn * BM + wc * 32 + 8 * fq;
#pragma unroll
        for (int ai = 0; ai < 2; ++ai)
#pragma unroll
            for (int m = 0; m < 4; ++m)
#pragma unroll
                for (int bj = 0; bj < 2; ++bj) { const size_t off = (size_t)(row0 + ai * HALF + m * 16) * D + col0 + bj * HALF;
                    acc[ai][bj][m][0] = *(const f32x4*)(xs + off) * inv_scale; acc[ai][bj][m][1] = *(const f32x4*)(xs + off + 4) * inv_scale; }
    }
    __device__ __forceinline__ void operator()(const f32x4 (&acc)[2][2][4][2], const Unit& u, int wr, int wc, int fr, int fq) const {
        const int row0 = u.pm * BM + wr * 64 + fr, col0 = u.pn * BM + wc * 32 + 8 * fq;
#pragma unroll
        for (int ai = 0; ai < 2; ++ai)
#pragma unroll
            for (int m = 0; m < 4; ++m) { const int row = row0 + ai * HALF + m * 16; float ss = 0.f;
#pragma unroll
                for (int bj = 0; bj < 2; ++bj) { const size_t off = (size_t)row * D + col0 + bj * HALF;
                    const f32x4 a = acc[ai][bj][m][0] * scale, b = acc[ai][bj][m][1] * scale;
                    *(f32x4*)(xd + off) = a; *(f32x4*)(xd + off + 4) = b; ss += dot4(a) + dot4(b);
                    *(u32x4*)(XB + off) = pack8(a, b); }
                ss += __shfl_xor(ss, 16); ss += __shfl_xor(ss, 32);
                if (fq == 0) PS[(size_t)row * 16 + u.pn * 4 + wc] = ss; }
    }
};
struct EpiMixIn {
    static constexpr bool PERM = true, AFTER_DRAIN = false, INIT_ACC = false, HAS_MID = false;
    bf16_t *U, *V, *T, *GB, *SA, *SB; const PG8_LAS float* RS; float* PSV;
    __device__ __forceinline__ void operator()(const f32x4 (&acc)[2][2][4][2], const Unit& u, int wr, int wc, int fr, int fq) const {
        const int pn = u.pn, row0 = u.pm * BM + wr * 64 + fr, cw = wc * 32 + 8 * fq;
        float rs[2][4]; rows_rstd(RS, wr, fr, rs);
        if (pn >= 12 && pn < 20) {
            const int col = (pn - 12) * 128 + cw; const rsrc_t rT = mk_rsrc(T, (size_t)M * D * 2);
#pragma unroll
            for (int ai = 0; ai < 2; ++ai)
#pragma unroll
                for (int m = 0; m < 4; ++m) { const int row = row0 + ai * HALF + m * 16; const float r2 = rs[ai][m] * rs[ai][m];
                    const f32x4 t0 = acc[ai][0][m][0] * acc[ai][1][m][0] * r2, t1 = acc[ai][0][m][1] * acc[ai][1][m][1] * r2;
                    st16_wt(rT, ((size_t)row * D + col) * 2, pack8(t0, t1)); }
        } else {
            bf16_t* O; int cb, act;
            if (pn < 4) { O = U; cb = pn * 256; act = 1; } else if (pn < 8) { O = V; cb = (pn - 4) * 256; act = 2; } else if (pn < 12) { O = GB; cb = (pn - 8) * 256; act = 0; }
            else if (pn < 24) { O = SA; cb = (pn - 20) * 256; act = 3; } else { O = SB; cb = (pn - 24) * 256; act = 3; }
            const rsrc_t rO = mk_rsrc(O, (size_t)M * D * 2);
#pragma unroll
            for (int ai = 0; ai < 2; ++ai)
#pragma unroll
                for (int m = 0; m < 4; ++m) { const int row = row0 + ai * HALF + m * 16; const float r = rs[ai][m]; float ss = 0.f;
#pragma unroll
                    for (int bj = 0; bj < 2; ++bj) { f32x4 v0 = acc[ai][bj][m][0] * r, v1 = acc[ai][bj][m][1] * r;
                        if (act == 1 || act == 2) { v0 = vgelu(v0); v1 = vgelu(v1); ss += dot4(v0) + dot4(v1); }
                        else if (act == 3) { v0 = vsig_from_t(v0 * (-1.44269504089f)); v1 = vsig_from_t(v1 * (-1.44269504089f)); }
                        st16_wt(rO, ((size_t)row * D + cb + bj * HALF + cw) * 2, pack8(v0, v1)); }
                    if (act == 2) { ss += __shfl_xor(ss, 16); ss += __shfl_xor(ss, 32); if (fq == 0) PSV[(size_t)row * 16 + (pn - 4) * 4 + wc] = ss; } }
        }
    }
};
struct EpiGate {
    static constexpr bool PERM = true, AFTER_DRAIN = false, INIT_ACC = false, HAS_MID = false;
    const bf16_t* GATE; bf16_t* O; int coff;
    __device__ __forceinline__ void operator()(const f32x4 (&acc)[2][2][4][2], const Unit& u, int wr, int wc, int fr, int fq) const {
        const int row0 = u.pm * BM + wr * 64 + fr, col0 = u.pn * BM + wc * 32 + 8 * fq;
        u32x4 g[2][4][2];
#pragma unroll
        for (int ai = 0; ai < 2; ++ai)
#pragma unroll
            for (int m = 0; m < 4; ++m)
#pragma unroll
                for (int bj = 0; bj < 2; ++bj) g[ai][m][bj] = *(const u32x4*)(GATE + (size_t)(row0 + ai * HALF + m * 16) * D + col0 + bj * HALF);
        PIN16(g);
#pragma unroll
        for (int ai = 0; ai < 2; ++ai)
#pragma unroll
            for (int m = 0; m < 4; ++m)
#pragma unroll
                for (int bj = 0; bj < 2; ++bj) { f32x4 g0, g1; unpack8(g[ai][m][bj], g0, g1);
                    *(u32x4*)(O + (size_t)(row0 + ai * HALF + m * 16) * (2 * D) + coff + col0 + bj * HALF) = pack8(g0 * acc[ai][bj][m][0], g1 * acc[ai][bj][m][1]); }
    }
};

struct EpiProj {
    static constexpr bool PERM = true, AFTER_DRAIN = false, INIT_ACC = false, HAS_MID = false;
    const bf16_t* GATE; bf16_t* ST; bf16_t* MG; bool second;
    __device__ __forceinline__ void operator()(const f32x4 (&acc)[2][2][4][2], const Unit& u, int wr, int wc, int fr, int fq) const {
        const int row0 = u.pm * BM + wr * 64 + fr, col0 = u.pn * BM + wc * 32 + 8 * fq;
        u32x4 w[2][4][2];
#pragma unroll
        for (int ai = 0; ai < 2; ++ai) {
            u32x4 g[4][2], p[4][2];
#pragma unroll
            for (int m = 0; m < 4; ++m)
#pragma unroll
                for (int bj = 0; bj < 2; ++bj) { const size_t off = (size_t)(row0 + ai * HALF + m * 16) * D + col0 + bj * HALF;
                    g[m][bj] = *(const u32x4*)(GATE + off); p[m][bj] = second ? *(const u32x4*)(ST + off) : (u32x4){0u, 0u, 0u, 0u}; }
#pragma unroll
            for (int m = 0; m < 4; ++m)
#pragma unroll
                for (int bj = 0; bj < 2; ++bj) { f32x4 g0, g1, p0, p1; unpack8(g[m][bj], g0, g1); unpack8(p[m][bj], p0, p1);
                    w[ai][m][bj] = pack8(p0 + g0 * acc[ai][bj][m][0], p1 + g1 * acc[ai][bj][m][1]); }
            asm volatile("" ::: "memory");
        }
        PIN16(w);
        const rsrc_t rO = mk_rsrc(second ? MG : ST, (size_t)M * D * 2);
#pragma unroll
        for (int ai = 0; ai < 2; ++ai)
#pragma unroll
            for (int m = 0; m < 4; ++m)
#pragma unroll
                for (int bj = 0; bj < 2; ++bj) st16_wt(rO, ((size_t)(row0 + ai * HALF + m * 16) * D + col0 + bj * HALF) * 2, w[ai][m][bj]);
    }
};

struct EpiMerge {
    static constexpr bool PERM = true, AFTER_DRAIN = false, INIT_ACC = false, HAS_MID = true;
    const bf16_t* SA; const bf16_t* SB; bf16_t* MG;
    __device__ __forceinline__ void mid(f32x4 (&acc)[2][2][4][2], const Unit& u, int wr, int wc, int fr, int fq) const {
        const int row0 = u.pm * BM + wr * 64 + fr, col0 = u.pn * BM + wc * 32 + 8 * fq;
        const rsrc_t rA = mk_rsrc(SA, (size_t)M * D * 2), rB = mk_rsrc(SB, (size_t)M * D * 2);
        const unsigned voff = (unsigned)((size_t)row0 * D + col0) * 2u;
#pragma unroll
        for (int ai = 0; ai < 2; ++ai) {
            u32x4 ga[4][2], gb[4][2];
#pragma unroll
            for (int m = 0; m < 4; ++m)
#pragma unroll
                for (int bj = 0; bj < 2; ++bj) { const unsigned so = (unsigned)(((ai * HALF + m * 16) * D + bj * HALF) * 2); ga[m][bj] = ld16_b(rA, voff, so); gb[m][bj] = ld16_b(rB, voff, so); }
#pragma unroll
            for (int m = 0; m < 4; ++m)
#pragma unroll
                for (int bj = 0; bj < 2; ++bj) { f32x4 a0, a1, b0, b1; unpack8(ga[m][bj], a0, a1); unpack8(gb[m][bj], b0, b1);
                    acc[ai][bj][m][0] = acc[ai][bj][m][0] * (a0 * vrcp(b0)); acc[ai][bj][m][1] = acc[ai][bj][m][1] * (a1 * vrcp(b1)); }
            asm volatile("" ::: "memory"); }
    }
    __device__ __forceinline__ void operator()(const f32x4 (&acc)[2][2][4][2], const Unit& u, int wr, int wc, int fr, int fq) const {
        const int row0 = u.pm * BM + wr * 64 + fr, col0 = u.pn * BM + wc * 32 + 8 * fq;
        u32x4 g[2][4][2];
#pragma unroll
        for (int ai = 0; ai < 2; ++ai)
#pragma unroll
            for (int m = 0; m < 4; ++m)
#pragma unroll
                for (int bj = 0; bj < 2; ++bj) g[ai][m][bj] = *(const u32x4*)(SB + (size_t)(row0 + ai * HALF + m * 16) * D + col0 + bj * HALF);
        PIN16(g);
        const rsrc_t rO = mk_rsrc(MG, (size_t)M * D * 2);
#pragma unroll
        for (int ai = 0; ai < 2; ++ai)
#pragma unroll
            for (int m = 0; m < 4; ++m)
#pragma unroll
                for (int bj = 0; bj < 2; ++bj) { f32x4 b0, b1; unpack8(g[ai][m][bj], b0, b1);
                    st16_wt(rO, ((size_t)(row0 + ai * HALF + m * 16) * D + col0 + bj * HALF) * 2, pack8(b0 * acc[ai][bj][m][0], b1 * acc[ai][bj][m][1])); }
    }
};

template <class Epi, class Sched, bool ALIGN_EPI = false, bool SP2 = false>
__device__ __forceinline__ void gemm_phase(PG8_LAS unsigned char* lds, const Gemm g, const Sched& S, const Epi& E) {
    int tid_ = threadIdx.x; asm volatile("" : "+v"(tid_));
    const int tid = tid_, wid = __builtin_amdgcn_readfirstlane(tid >> 6), lane = tid & 63, wr = wid >> 2, wc = wid & 3, fr = lane & 15, fq = lane >> 4;
    const int K = g.K, nt = K / BK, lda = g.lda ? g.lda : K, ldb = g.ldb ? g.ldb : K, ks = g.ksplit;
    unsigned voffA[2], voffB[2];
#pragma unroll
    for (int i = 0; i < 2; ++i) { int R, C; stage_rc(tid * 16 + i * 8192, R, C); const int Rb = Epi::PERM ? ((R & ~31) + perm32(R & 31)) : R;
        voffA[i] = (unsigned)(R * lda + C) * 2u; voffB[i] = (unsigned)(Rb * ldb + C) * 2u; }
    const size_t kstep = (size_t)(BK * 2);
    const size_t hstepA = (size_t)HALF * lda * 2, hstepB = (size_t)HALF * ldb * 2;
    const size_t tstepA = 2 * hstepA, tstepB = 2 * hstepB;
    const unsigned ldsw = (unsigned)wid * 1024u;
    const int aoff = lds_byte(wr * 64 + fr, fq * 8), boff = lds_byte(wc * 32 + fr, fq * 8);
#define PG8_SA(b, h) (((b) * 2 + (h)) * HTB)
#define PG8_SB(b, h) ((4 + (b) * 2 + (h)) * HTB)
#define PG8_STAGE(bufoff, gbase, voff) do { _Pragma("unroll") for (int _i = 0; _i < 2; ++_i) \
        __builtin_amdgcn_global_load_lds((const unsigned*)((const char*)(gbase) + (voff)[_i]), (PG8_LAS unsigned*)(lds + (bufoff) + ldsw + _i * 8192), 16, 0, 0); } while (0)
#define PG8_LDA(dst, b, h) do { _Pragma("unroll") for (int m = 0; m < 4; ++m) _Pragma("unroll") for (int k = 0; k < 2; ++k) dst[m][k] = *(const PG8_LAS bf16x8*)(lds + PG8_SA(b, h) + aoff + m * 2048 + k * 1024); } while (0)
#define PG8_LDB(dst, b, h) do { _Pragma("unroll") for (int n = 0; n < 2; ++n) _Pragma("unroll") for (int k = 0; k < 2; ++k) dst[n][k] = *(const PG8_LAS bf16x8*)(lds + PG8_SB(b, h) + boff + n * 2048 + k * 1024); } while (0)
#define PG8_MMA(ai, bj, At, Bt) do { __builtin_amdgcn_s_setprio(1); _Pragma("unroll") for (int m = 0; m < 4; ++m) _Pragma("unroll") for (int n = 0; n < 2; ++n) _Pragma("unroll") for (int k = 0; k < 2; ++k) \
        acc[ai][bj][m][n] = __builtin_amdgcn_mfma_f32_16x16x32_bf16(Bt[n][k], At[m][k], acc[ai][bj][m][n], 0, 0, 0); __builtin_amdgcn_s_setprio(0); } while (0)
#define PG8_WAIT_V(n) asm volatile("s_waitcnt vmcnt(" #n ")" ::: "memory")
#define PG8_WAIT_L(n) asm volatile("s_waitcnt lgkmcnt(" #n ")" ::: "memory")
#define PG8_BAR __builtin_amdgcn_s_barrier()
#define PG8_SCHED __builtin_amdgcn_sched_barrier(0)
    Unit cur, nxt; int ui = 0;
    if (!S.next(0, cur)) return;
    f32x4 acc[2][2][4][2];
#pragma unroll
    for (int a = 0; a < 2; ++a)
#pragma unroll
        for (int b = 0; b < 2; ++b)
#pragma unroll
            for (int m = 0; m < 4; ++m)
#pragma unroll
                for (int n = 0; n < 2; ++n) acc[a][b][m][n] = (f32x4){0.f, 0.f, 0.f, 0.f};
    if constexpr (Epi::INIT_ACC) E.init(acc, cur, wr, wc, fr, fq);
    bf16x8 At[4][2], B0[2][2], B1[2][2];
    const char* cA = (const char*)g.A + (size_t)cur.pm * tstepA; const char* cB = (const char*)g.Bt + (size_t)cur.pn * tstepB;
    S.a_ready(cur);
    if constexpr (SP2) {
        PG8_STAGE(PG8_SB(0, 0), cB, voffB); PG8_STAGE(PG8_SB(0, 1), cB + hstepB, voffB); PG8_STAGE(PG8_SA(0, 0), cA, voffA); PG8_STAGE(PG8_SA(0, 1), cA + hstepA, voffA);
        if (wr == 1) PG8_BAR;
        PG8_WAIT_V(2); PG8_BAR;
        PG8_STAGE(PG8_SB(1, 0), cB + kstep, voffB); PG8_STAGE(PG8_SA(1, 0), cA + kstep, voffA); PG8_STAGE(PG8_SB(1, 1), cB + hstepB + kstep, voffB);
        PG8_WAIT_V(6); PG8_BAR;
    } else {
        PG8_STAGE(PG8_SB(0, 0), cB, voffB); PG8_STAGE(PG8_SA(0, 0), cA, voffA); PG8_STAGE(PG8_SB(0, 1), cB + hstepB, voffB); PG8_STAGE(PG8_SA(0, 1), cA + hstepA, voffA);
        if (wr == 1) PG8_BAR;
        PG8_WAIT_V(4); PG8_BAR;
        PG8_STAGE(PG8_SB(1, 0), cB + kstep, voffB); PG8_STAGE(PG8_SA(1, 0), cA + kstep, voffA); PG8_STAGE(PG8_SB(1, 1), cB + hstepB + kstep, voffB);
        PG8_WAIT_V(6); PG8_BAR;
    }
    for (;;) {
        const bool has_next = S.next(ui + 1, nxt);
        const char* nA = has_next ? (const char*)g.A + (size_t)nxt.pm * tstepA : cA; const char* nB = has_next ? (const char*)g.Bt + (size_t)nxt.pn * tstepB : cB;
        const char* cA2 = (const char*)g.A2 + (size_t)cur.pm * tstepA; const char* cB2 = (const char*)g.Bt2 + (size_t)cur.pn * tstepB;
        const int tsplit = (Epi::HAS_MID && ks) ? ks : nt;
        for (int seg = 0, t0 = 0; t0 < nt; ++seg) { const int t1 = (seg == 0) ? tsplit : nt;
        if constexpr (Epi::HAS_MID) { if (seg) E.mid(acc, cur, wr, wc, fr, fq); }
        for (int t = t0; t < t1; t += 2) {
            const bool last = (t == nt - 2);
            const bool s1 = ks && (t + 1 >= ks), s2 = ks && (t + 2 >= ks);
            const char* a1 = s1 ? cA2 + (size_t)(t + 1 - ks) * kstep : cA + (size_t)(t + 1) * kstep;
            const char* a2 = last ? nA : (s2 ? cA2 + (size_t)(t + 2 - ks) * kstep : cA + (size_t)(t + 2) * kstep); const char* b2 = last ? nB : (s2 ? cB2 + (size_t)(t + 2 - ks) * kstep : cB + (size_t)(t + 2) * kstep);
            const char* a3 = a2 + kstep; const char* b3 = b2 + kstep;
            if (last && has_next) S.a_ready(nxt);
            if constexpr (SP2) {
            PG8_LDB(B0, 0, 0); PG8_LDB(B1, 0, 1); PG8_SCHED; PG8_LDA(At, 0, 0); PG8_STAGE(PG8_SA(1, 1), a1 + hstepA, voffA);
            PG8_WAIT_V(8); PG8_WAIT_L(0); PG8_BAR; PG8_MMA(0, 0, At, B0); PG8_MMA(0, 1, At, B1); PG8_BAR; PG8_SCHED;
            PG8_LDA(At, 0, 1); PG8_STAGE(PG8_SB(0, 0), b2, voffB); PG8_STAGE(PG8_SB(0, 1), b2 + hstepB, voffB); PG8_STAGE(PG8_SA(0, 0), a2, voffA);
            PG8_WAIT_V(8); PG8_WAIT_L(0); PG8_BAR; PG8_MMA(1, 0, At, B0); PG8_MMA(1, 1, At, B1); PG8_BAR; PG8_SCHED;
            PG8_LDB(B0, 1, 0); PG8_LDB(B1, 1, 1); PG8_SCHED; PG8_LDA(At, 1, 0); PG8_STAGE(PG8_SA(0, 1), a2 + hstepA, voffA);
            PG8_WAIT_V(8); PG8_WAIT_L(0); PG8_BAR; PG8_MMA(0, 0, At, B0); PG8_MMA(0, 1, At, B1); PG8_BAR; PG8_SCHED;
            PG8_LDA(At, 1, 1); PG8_STAGE(PG8_SB(1, 0), b3, voffB); PG8_STAGE(PG8_SB(1, 1), b3 + hstepB, voffB); PG8_STAGE(PG8_SA(1, 0), a3, voffA);
            PG8_WAIT_V(8); PG8_WAIT_L(0); PG8_BAR; PG8_MMA(1, 0, At, B0); PG8_MMA(1, 1, At, B1); PG8_BAR; PG8_SCHED;
            } else {
            PG8_LDB(B0, 0, 0); PG8_SCHED; PG8_LDA(At, 0, 0); PG8_STAGE(PG8_SA(1, 1), a1 + hstepA, voffA);
            PG8_WAIT_L(8); PG8_BAR; PG8_WAIT_L(0); PG8_MMA(0, 0, At, B0); PG8_BAR; PG8_SCHED;
            PG8_LDB(B1, 0, 1); PG8_STAGE(PG8_SB(0, 0), b2, voffB);
            PG8_BAR; PG8_WAIT_L(0); PG8_MMA(0, 1, At, B1); PG8_BAR;
            PG8_LDA(At, 0, 1); PG8_STAGE(PG8_SA(0, 0), a2, voffA);
            PG8_BAR; PG8_WAIT_L(0); PG8_MMA(1, 0, At, B0); PG8_BAR; PG8_SCHED;
            PG8_STAGE(PG8_SB(0, 1), b2 + hstepB, voffB);
            PG8_WAIT_V(6); PG8_BAR; PG8_MMA(1, 1, At, B1); PG8_BAR;
            PG8_LDB(B0, 1, 0); PG8_SCHED; PG8_LDA(At, 1, 0); PG8_STAGE(PG8_SA(0, 1), a2 + hstepA, voffA);
            PG8_WAIT_L(8); PG8_BAR; PG8_WAIT_L(0); PG8_MMA(0, 0, At, B0); PG8_BAR; PG8_SCHED;
            PG8_LDB(B1, 1, 1); PG8_STAGE(PG8_SB(1, 0), b3, voffB);
            PG8_BAR; PG8_WAIT_L(0); PG8_MMA(0, 1, At, B1); PG8_BAR;
            PG8_LDA(At, 1, 1); PG8_STAGE(PG8_SA(1, 0), a3, voffA);
            PG8_BAR; PG8_WAIT_L(0); PG8_MMA(1, 0, At, B0); PG8_BAR; PG8_SCHED;
            PG8_STAGE(PG8_SB(1, 1), b3 + hstepB, voffB);
            PG8_WAIT_V(6); PG8_BAR; PG8_MMA(1, 1, At, B1); PG8_BAR;
            }
        }
        t0 = t1; }
        if constexpr (ALIGN_EPI) { if (wr == 0) PG8_BAR; }
        if constexpr (!Epi::AFTER_DRAIN) { E(acc, cur, wr, wc, fr, fq); S.done(cur); }
        if (!has_next) break;
#pragma unroll
        for (int a = 0; a < 2; ++a)
#pragma unroll
            for (int b = 0; b < 2; ++b)
#pragma unroll
                for (int m = 0; m < 4; ++m)
#pragma unroll
                    for (int n = 0; n < 2; ++n) acc[a][b][m][n] = (f32x4){0.f, 0.f, 0.f, 0.f};
        if constexpr (Epi::INIT_ACC) E.init(acc, nxt, wr, wc, fr, fq);
        cur = nxt; cA = nA; cB = nB; ++ui;
        if constexpr (ALIGN_EPI) { if (wr == 1) PG8_BAR; }
    }
    PG8_WAIT_V(0);
    if constexpr (!ALIGN_EPI) { if (wr == 0) PG8_BAR; }
    PG8_BAR;
    if constexpr (Epi::AFTER_DRAIN) { E.fused(acc, cur, wr, wc, fr, fq, lds, wid, lane); S.done(cur); }
#undef PG8_SA
#undef PG8_SB
#undef PG8_STAGE
#undef PG8_LDA
#undef PG8_LDB
#undef PG8_MMA
#undef PG8_WAIT_V
#undef PG8_WAIT_L
#undef PG8_BAR
#undef PG8_SCHED
}
}
#define LAS __attribute__((address_space(3)))
#define RLX_AGENT __ATOMIC_RELAXED, __HIP_MEMORY_SCOPE_AGENT
#define XB_TMO      128
#define XB_XCNT(j)  (256  + 64 * (j))
#define XB_XSUB(j)  (1280 + 64 * (j))
#define XB_XGEN(j)  (2304 + 64 * (j))
#define XB_TOP      3328
#define XB_TOPGEN   3392
#define XCD_BAR_WORDS 3456
#define XB_SPIN_CAP (1u << 18)

__device__ __forceinline__ unsigned xb_ld(unsigned* p)              { return __hip_atomic_load(p, __ATOMIC_RELAXED, __HIP_MEMORY_SCOPE_AGENT); }
__device__ __forceinline__ unsigned xb_add(unsigned* p, unsigned v) { return __hip_atomic_fetch_add(p, v, __ATOMIC_RELAXED, __HIP_MEMORY_SCOPE_AGENT); }
__device__ __forceinline__ unsigned xb_xcc_id() { return (unsigned)__builtin_amdgcn_s_getreg((3 << 11) | 20) & 0xFu; }
#define XB_SPIN(cond, bar) do { unsigned _sp = 0; while (cond) { __builtin_amdgcn_s_sleep(1); \
    if ((++_sp & 255u) == 0u) { if (xb_ld(&(bar)[XB_TMO])) break; if (_sp > XB_SPIN_CAP) { atomicAdd(&(bar)[XB_TMO], 1u); break; } } } } while (0)

struct XcdBarrier {
    unsigned* bar; unsigned x;
    volatile LAS unsigned* st;
};

__device__ __forceinline__ XcdBarrier xcd_barrier_post(unsigned* bar, volatile LAS unsigned* st) {
    XcdBarrier b; b.bar = bar; b.x = xb_xcc_id(); b.st = st;
    if (threadIdx.x == 0) { const unsigned rank = xb_add(&bar[XB_XCNT(b.x)], 1u); st[2] = rank; st[3] = b.x; }
    return b;
}
__device__ __forceinline__ void xcd_barrier_complete(unsigned* bar, unsigned x, unsigned& nloc, unsigned& nx) {
    const unsigned G = gridDim.x * gridDim.y * gridDim.z;
    unsigned sum, cnt, mine, sp = 0u;
    for (;;) {
        sum = 0u; cnt = 0u; mine = 0u;
#pragma unroll
        for (unsigned j = 0; j < 16; ++j) { const unsigned c = xb_ld(&bar[XB_XCNT(j)]); sum += c; cnt += (c > 0u) ? 1u : 0u; mine = (j == x) ? c : mine; }
        if (sum == G) break;
        __builtin_amdgcn_s_sleep(1);
        if ((++sp & 255u) == 0u) { if (xb_ld(&bar[XB_TMO])) break; if (sp > XB_SPIN_CAP) { atomicAdd(&bar[XB_TMO], 1u); break; } }
    }
    nloc = mine > 0u ? mine : 1u; nx = cnt > 0u ? cnt : 1u;
}

__device__ __forceinline__ void xcd_barrier(const XcdBarrier& b) {
    asm volatile("s_waitcnt vmcnt(0)" ::: "memory");
    __syncthreads();
    if (threadIdx.x == 0) {
        unsigned* bar = b.bar;
        __builtin_amdgcn_s_waitcnt(0);
        unsigned nloc = b.st[0], nx = b.st[1];
        if (nloc == 0u) { xcd_barrier_complete(bar, b.x, nloc, nx); b.st[0] = nloc; b.st[1] = nx; }
        const unsigned old = xb_add(&bar[XB_XSUB(b.x)], 1u);
        const unsigned gen = old / nloc;
        if (old + 1u == (gen + 1u) * nloc) {
            __builtin_amdgcn_fence(__ATOMIC_RELEASE, "agent");
            asm volatile("s_waitcnt vmcnt(0)" ::: "memory");
            const unsigned og = xb_add(&bar[XB_TOP], 1u);
            const unsigned tg = og / nx;
            if (og + 1u == (tg + 1u) * nx) xb_add(&bar[XB_TOPGEN], 1u);
            else XB_SPIN(xb_ld(&bar[XB_TOPGEN]) == tg, bar);
            __builtin_amdgcn_fence(__ATOMIC_ACQUIRE, "agent");
            xb_add(&bar[XB_XGEN(b.x)], 1u);
            asm volatile("s_waitcnt vmcnt(0)" ::: "memory");
        } else {
            XB_SPIN(xb_ld(&bar[XB_XGEN(b.x)]) == gen, bar);
            __builtin_amdgcn_fence(__ATOMIC_ACQUIRE, "agent");
            asm volatile("s_waitcnt vmcnt(0)" ::: "memory");
        }
    }
    __syncthreads();
}
#undef LAS

#ifndef GATE2048
#define GATE2048 0
#endif
#define LAS __attribute__((address_space(3)))
typedef unsigned short bf16;
typedef float f32x4 __attribute__((ext_vector_type(4)));
typedef unsigned u32x4 __attribute__((ext_vector_type(4)));
typedef unsigned u32x2 __attribute__((ext_vector_type(2)));
typedef short bf16x8 __attribute__((ext_vector_type(8)));
constexpr int NWAVES = 8, NTHREADS = 512;
constexpr int LDS_BYTES = 147456;
constexpr int MISC_OFF = 131072;
constexpr size_t MiB = 1u << 20;
constexpr size_t WS_CTL = 0, CTL_BYTES = 1 * MiB;
constexpr size_t WS_PS = 1 * MiB, WS_PSV = 2 * MiB;
constexpr size_t WS_XB = 4 * MiB;
constexpr size_t WS_ACT = 36 * MiB;
constexpr size_t A_H = 0;
constexpr size_t A_U = 0, A_V = 32 * MiB, A_T = 64 * MiB, A_GB = 96 * MiB, A_SA = 128 * MiB, A_SB = 160 * MiB;
constexpr size_t WS_W = 228 * MiB;
constexpr size_t E_FIN = (size_t)2 * FF * D, E_FOUT = (size_t)D * FF, E_WIN = (size_t)NIN * D, E_SQ = (size_t)D * D;
constexpr size_t O_F1I = 0, O_F1O = O_F1I + E_FIN, O_WIN = O_F1O + E_FOUT, O_PA = O_WIN + E_WIN, O_PB = O_PA + E_SQ, O_WO = O_PB + E_SQ, O_F2I = O_WO + (GATE2048 ? 2 : 1) * E_SQ, O_F2O = O_F2I + E_FIN, E_LAYER = O_F2O + E_FOUT;
constexpr size_t WS_XL = WS_W + (size_t)DEPTH * E_LAYER * 2;
constexpr size_t WS_END = WS_XL + (size_t)M * D * 2;
static_assert(E_LAYER * 2 == (GATE2048 ? 55 : 53) * MiB, "layer weight bytes");
static_assert((size_t)M * FF * 2 <= 192 * MiB, "H fits");

__device__ __forceinline__ float wave_sum(float v) {
#pragma unroll
    for (int o = 1; o < 64; o <<= 1) v += __shfl_xor(v, o);
    return v;
}
#define LDS_WAIT() asm volatile("s_waitcnt lgkmcnt(0)" ::: "memory")

__device__ __forceinline__ int colmap(int mode, int n) {
    if (mode == 1) { const int pn = n >> 8, half = (n >> 7) & 1, jj = n & 127; return half * FF + pn * 128 + jj; }
    if (mode == 2) { if (n < 3072 || n >= 5120) return n; const int r = n - 3072, q = r >> 8, half = (r >> 7) & 1, jj = r & 127; return 3072 + half * 1024 + q * 128 + jj; }
    return n;
}
__device__ __forceinline__ void transpose_item(const float* W, int K, int Nsrc, int Ndst, int mode, const float* scale, bf16* WT, LAS unsigned* scr, int item, int lane, int ldk = 0) {
    if (ldk == 0) ldk = K;
    const int nblk = Ndst / 64, kb = item / nblk, nb = item % nblk, k0 = 64 * kb, n0 = 64 * nb, s0 = colmap(mode, n0);
    const int r = lane >> 4, c = lane & 15;
    f32x4 v[8][2];
#pragma unroll
    for (int jj = 0; jj < 8; ++jj) { const float* p = W + (size_t)(k0 + 2 * (4 * jj + r)) * Nsrc + s0 + 4 * c; v[jj][0] = *(const f32x4*)p; v[jj][1] = *(const f32x4*)(p + Nsrc); }
#pragma unroll
    for (int jj = 0; jj < 8; ++jj) { const int j = 4 * jj + r; float sa = 1.f, sb = 1.f; if (scale) { sa = scale[k0 + 2 * j]; sb = scale[k0 + 2 * j + 1]; }
        u32x4 w; w.x = pg8::cvt_pk_bf16(v[jj][0][0] * sa, v[jj][1][0] * sb); w.y = pg8::cvt_pk_bf16(v[jj][0][1] * sa, v[jj][1][1] * sb); w.z = pg8::cvt_pk_bf16(v[jj][0][2] * sa, v[jj][1][2] * sb); w.w = pg8::cvt_pk_bf16(v[jj][0][3] * sa, v[jj][1][3] * sb);
        *(LAS u32x4*)(scr + j * 68 + 4 * c) = w; }
    LDS_WAIT(); asm volatile("" ::: "memory");
    const int cc = lane & 7;
#pragma unroll
    for (int jj = 0; jj < 8; ++jj) { const int n = (lane >> 3) + 8 * jj; const LAS unsigned* s = scr + (4 * cc) * 68 + n;
        u32x4 o; o.x = s[0]; o.y = s[68]; o.z = s[136]; o.w = s[204];
        *(u32x4*)(WT + (size_t)(n0 + n) * ldk + k0 + 8 * cc) = o; }
    LDS_WAIT(); asm volatile("" ::: "memory");
}

struct Args { const float* in[17]; float* out; unsigned char* ws; int ph_lo, ph_hi; };
enum { I_X = 0, I_F1N, I_F1I, I_F1O, I_MN, I_WIN, I_SGN, I_SGW, I_SGB, I_CW, I_PA, I_PB, I_WO, I_F2N, I_F2I, I_F2O, I_FN };

__device__ __forceinline__ void convert_layer(const __attribute__((address_space(4))) Args* ap, LAS unsigned char* lds, int l, int lo, int hi, int widx, int nw, int wave, int lane) {
    LAS unsigned* scr = (LAS unsigned*)(lds + wave * 16384);
    bf16* wl = (bf16*)(ap->ws + WS_W) + (size_t)l * E_LAYER;
    constexpr int IT_FIN = (D / 64) * (2 * FF / 64), IT_FOUT = (FF / 64) * (D / 64), IT_WIN = (D / 64) * (NIN / 64), IT_SQ = (D / 64) * (D / 64);
    for (int g = lo + widx; g < hi; g += nw) {
        int r = g;
        if (r < IT_FIN) { transpose_item(ap->in[I_F1I] + (size_t)l * D * 2 * FF, D, 2 * FF, 2 * FF, 1, ap->in[I_F1N] + l * D, wl + O_F1I, scr, r, lane); continue; } r -= IT_FIN;
        if (r < IT_FOUT) { transpose_item(ap->in[I_F1O] + (size_t)l * FF * D, FF, D, D, 0, nullptr, wl + O_F1O, scr, r, lane); continue; } r -= IT_FOUT;
        if (r < IT_WIN) { transpose_item(ap->in[I_WIN] + (size_t)l * D * NIN, D, NIN, NIN, 2, ap->in[I_MN] + l * D, wl + O_WIN, scr, r, lane); continue; } r -= IT_WIN;
        if (r < IT_SQ) { transpose_item(ap->in[I_PA] + (size_t)l * D * D, D, D, D, 0, nullptr, wl + O_PA, scr, r, lane); continue; } r -= IT_SQ;
        if (r < IT_SQ) { transpose_item(ap->in[I_PB] + (size_t)l * D * D, D, D, D, 0, nullptr, wl + O_PB, scr, r, lane); continue; } r -= IT_SQ;
#if GATE2048
        if (r < IT_SQ) { transpose_item(ap->in[I_WO] + (size_t)l * D * D, D, D, D, 0, nullptr, wl + O_WO, scr, r, lane, 2 * D); continue; } r -= IT_SQ;
        if (r < IT_SQ) { transpose_item(ap->in[I_WO] + (size_t)l * D * D, D, D, D, 0, nullptr, wl + O_WO + D, scr, r, lane, 2 * D); continue; } r -= IT_SQ;
#else
        if (r < IT_SQ) { transpose_item(ap->in[I_WO] + (size_t)l * D * D, D, D, D, 0, nullptr, wl + O_WO, scr, r, lane); continue; } r -= IT_SQ;
#endif
        if (r < IT_FIN) { transpose_item(ap->in[I_F2I] + (size_t)l * D * 2 * FF, D, 2 * FF, 2 * FF, 1, ap->in[I_F2N] + l * D, wl + O_F2I, scr, r, lane); continue; } r -= IT_FIN;
        transpose_item(ap->in[I_F2O] + (size_t)l * FF * D, FF, D, D, 0, nullptr, wl + O_F2O, scr, r, lane);
    }
}
constexpr int IT_LAYER = 2 * ((D / 64) * (2 * FF / 64)) + 2 * ((FF / 64) * (D / 64)) + (D / 64) * (NIN / 64) + (GATE2048 ? 4 : 3) * ((D / 64) * (D / 64));
__device__ __forceinline__ void prologue(const __attribute__((address_space(4))) Args* ap, LAS unsigned char* lds, int gw, int NGW, int wave, int lane) {
    convert_layer(ap, lds, 0, 0, IT_LAYER / 2, gw, NGW, wave, lane);
    const float* x = ap->in[I_X]; bf16* XB = (bf16*)(ap->ws + WS_XB); bf16* XL = (bf16*)(ap->ws + WS_XL); float* PS = (float*)(ap->ws + WS_PS);
    for (int m0 = gw * 4; m0 < M; m0 += NGW * 4) {
        f32x4 v[4][4]; float s[4];
#pragma unroll
        for (int q = 0; q < 4; ++q)
#pragma unroll
            for (int j = 0; j < 4; ++j) v[q][j] = ((const f32x4*)(x + (size_t)(m0 + q) * D) + lane)[64 * j];
#pragma unroll
        for (int q = 0; q < 4; ++q) { float t = 0.f;
#pragma unroll
            for (int j = 0; j < 4; ++j) t += pg8::dot4(v[q][j]);
            s[q] = wave_sum(t); }
        asm volatile("" : "+v"(s[0]), "+v"(s[1]), "+v"(s[2]), "+v"(s[3]) :: "memory");
#pragma unroll
        for (int q = 0; q < 4; ++q) { u32x2* o8 = (u32x2*)(XB + (size_t)(m0 + q) * D) + lane; u32x2* l8 = (u32x2*)(XL + (size_t)(m0 + q) * D) + lane;
#pragma unroll
            for (int j = 0; j < 4; ++j) { u32x2 w; w.x = pg8::cvt_pk_bf16(v[q][j][0], v[q][j][1]); w.y = pg8::cvt_pk_bf16(v[q][j][2], v[q][j][3]); o8[64 * j] = w;
                const f32x4 hf = (f32x4){pg8::bflo(w.x), pg8::bfhi(w.x), pg8::bflo(w.y), pg8::bfhi(w.y)}, d = v[q][j] - hf; u32x2 wl2; wl2.x = pg8::cvt_pk_bf16(d[0], d[1]); wl2.y = pg8::cvt_pk_bf16(d[2], d[3]); if (USE_XL) l8[64 * j] = wl2; }
            if (lane < 16) PS[(size_t)(m0 + q) * 16 + lane] = lane == 0 ? s[q] : 0.f; }
    }
}

struct SguLoads { u32x4 v[4]; f32x4 ps[4]; u32x2 u[4][2]; };
__device__ __forceinline__ void sgu_issue(SguLoads& L, int c, int h, const bf16* U, const bf16* V, const float* PSV, int tid) {
    const int R0 = c * CHUNK, C0 = h * 128, p = tid & 127, dq = tid >> 7;
    const int lane = tid & 63, wid = tid >> 6, wr = wid >> 2, wc = wid & 3, fr = lane & 15, fq = lane >> 4;
#pragma unroll
    for (int i = 0; i < 4; ++i) L.v[i] = *(const u32x4*)(V + (size_t)(R0 + p) * D + C0 + (dq + 4 * i) * 8);
#pragma unroll
    for (int i = 0; i < 4; ++i) L.ps[i] = *(const f32x4*)(PSV + (size_t)(R0 + p) * 16 + 4 * i);
#pragma unroll
    for (int m = 0; m < 4; ++m)
#pragma unroll
        for (int n = 0; n < 2; ++n) L.u[m][n] = *(const u32x2*)(U + (size_t)(R0 + wr * 64 + m * 16 + fr) * D + C0 + wc * 32 + n * 16 + 4 * fq);
}
__device__ __forceinline__ void sgu_phase(LAS unsigned char* lds, int bx, int G, const bf16* U, bf16* UO, const bf16* V, const float* PSV, const float* sgw_l, const float* sgb_l, const float* sgn_l, int tid) {
    LAS bf16* As = (LAS bf16*)lds;
    LAS bf16* Vt = (LAS bf16*)(lds + 34816);
    const int NT = (M / CHUNK) * HEADS;
    if (bx >= NT) return;
    const int h = bx & 7;
    const float* wsh = sgw_l + (size_t)h * CHUNK * CHUNK; const float* bsh = sgb_l + h * CHUNK; const float* gn = sgn_l + h * 128;
    const int lane = tid & 63, wid = tid >> 6, wr = wid >> 2, wc = wid & 3, fr = lane & 15, fq = lane >> 4;
    SguLoads L; sgu_issue(L, bx >> 3, h, U, V, PSV, tid);
#pragma unroll
    for (int i = 0; i < 4; ++i) { const int it = tid + i * NTHREADS, q = it >> 4, p8 = (it & 15) * 8; const float* src = wsh + q * 128 + p8;
        *(LAS u32x4*)(As + q * 136 + p8) = pg8::pack8(*(const f32x4*)src, *(const f32x4*)(src + 4)); }
    f32x4 gv[2]; float bq[4];
#pragma unroll
    for (int n = 0; n < 2; ++n) gv[n] = *(const f32x4*)(gn + wc * 32 + n * 16 + 4 * fq);
#pragma unroll
    for (int m = 0; m < 4; ++m) bq[m] = bsh[wr * 64 + m * 16 + fr];
    for (int t = bx; t < NT; t += G) {
        const int c = t >> 3, R0 = c * CHUNK, C0 = h * 128, p = tid & 127, dq = tid >> 7;
        const float rsp = rsqrtf(((pg8::sum4(L.ps[0]) + pg8::sum4(L.ps[1])) + (pg8::sum4(L.ps[2]) + pg8::sum4(L.ps[3]))) * (1.0f / 1024.0f) + EPS);
#pragma unroll
        for (int i = 0; i < 4; ++i) { f32x4 a, b; pg8::unpack8(L.v[i], a, b); const u32x4 w = pg8::pack8(a * rsp, b * rsp); LAS bf16* dst = Vt + (dq + 4 * i) * 8 * 136 + p;
            dst[0 * 136] = (bf16)(w.x & 0xffffu); dst[1 * 136] = (bf16)(w.x >> 16); dst[2 * 136] = (bf16)(w.y & 0xffffu); dst[3 * 136] = (bf16)(w.y >> 16);
            dst[4 * 136] = (bf16)(w.z & 0xffffu); dst[5 * 136] = (bf16)(w.z >> 16); dst[6 * 136] = (bf16)(w.w & 0xffffu); dst[7 * 136] = (bf16)(w.w >> 16); }
        u32x2 uc[4][2];
#pragma unroll
        for (int m = 0; m < 4; ++m)
#pragma unroll
            for (int n = 0; n < 2; ++n) uc[m][n] = L.u[m][n];
        asm volatile("" : "+v"(uc[0][0]), "+v"(uc[0][1]), "+v"(uc[1][0]), "+v"(uc[1][1]), "+v"(uc[2][0]), "+v"(uc[2][1]), "+v"(uc[3][0]), "+v"(uc[3][1]) :: "memory");
        if (t + G < NT) sgu_issue(L, (t + G) >> 3, h, U, V, PSV, tid);
        __syncthreads();
        f32x4 acc[4][2];
#pragma unroll
        for (int m = 0; m < 4; ++m)
#pragma unroll
            for (int n = 0; n < 2; ++n) acc[m][n] = (f32x4){0.f, 0.f, 0.f, 0.f};
#pragma unroll
        for (int kk = 0; kk < 4; ++kk) { bf16x8 af[4], bf[2];
#pragma unroll
            for (int m = 0; m < 4; ++m) af[m] = *(const LAS bf16x8*)(As + (wr * 64 + m * 16 + fr) * 136 + kk * 32 + fq * 8);
#pragma unroll
            for (int n = 0; n < 2; ++n) bf[n] = *(const LAS bf16x8*)(Vt + (wc * 32 + n * 16 + fr) * 136 + kk * 32 + fq * 8);
#pragma unroll
            for (int m = 0; m < 4; ++m)
#pragma unroll
                for (int n = 0; n < 2; ++n) acc[m][n] = __builtin_amdgcn_mfma_f32_16x16x32_bf16(bf[n], af[m], acc[m][n], 0, 0, 0); }
#pragma unroll
        for (int m = 0; m < 4; ++m)
#pragma unroll
            for (int n = 0; n < 2; ++n) { bf16* uo = UO + (size_t)(R0 + wr * 64 + m * 16 + fr) * D + C0 + wc * 32 + n * 16 + 4 * fq;
                const f32x4 uu = (f32x4){pg8::bflo(uc[m][n].x), pg8::bfhi(uc[m][n].x), pg8::bflo(uc[m][n].y), pg8::bfhi(uc[m][n].y)};
                const f32x4 o = uu * (gv[n] * acc[m][n] + bq[m]);
                u32x2 w; w.x = pg8::cvt_pk_bf16(o[0], o[1]); w.y = pg8::cvt_pk_bf16(o[2], o[3]); *(u32x2*)uo = w; }
        __syncthreads();
    }
}

__device__ __forceinline__ void conv_phase(const bf16* GB, bf16* GBO, const bf16* T, const float* cw, int gtid, int nthr) {
    constexpr int RPS = 16;
    for (int it = gtid; it < (M / RPS) * (D / 8); it += nthr) { const int c8 = (it & 127) * 8, r0 = (it >> 7) * RPS;
        const f32x4 w00 = *(const f32x4*)(cw + c8), w01 = *(const f32x4*)(cw + c8 + 4), w10 = *(const f32x4*)(cw + D + c8), w11 = *(const f32x4*)(cw + D + c8 + 4), w20 = *(const f32x4*)(cw + 2 * D + c8), w21 = *(const f32x4*)(cw + 2 * D + c8 + 4);
#pragma unroll
        for (int hb = 0; hb < 2; ++hb) { const int rb = r0 + 8 * hb; const size_t off = (size_t)rb * D + c8;
            u32x4 t[10], g[8]; const u32x4 z = (u32x4){0u, 0u, 0u, 0u};
            t[0] = ((rb & (SEQ - 1)) > 0) ? *(const u32x4*)(T + off - D) : z;
#pragma unroll
            for (int j = 0; j < 8; ++j) { t[j + 1] = *(const u32x4*)(T + off + (size_t)j * D); g[j] = *(const u32x4*)(GB + off + (size_t)j * D); }
            t[9] = (((rb + 7) & (SEQ - 1)) < SEQ - 1) ? *(const u32x4*)(T + off + (size_t)8 * D) : z;
            u32x4 o[8];
#pragma unroll
            for (int j = 0; j < 8; ++j) { f32x4 a0, a1, b0, b1, c0, c1, g0, g1; pg8::unpack8(t[j], a0, a1); pg8::unpack8(t[j + 1], b0, b1); pg8::unpack8(t[j + 2], c0, c1); pg8::unpack8(g[j], g0, g1);
                o[j] = pg8::pack8(g0 * (w00 * a0 + w10 * b0 + w20 * c0), g1 * (w01 * a1 + w11 * b1 + w21 * c1)); }
            asm volatile("" : "+v"(o[0]), "+v"(o[1]), "+v"(o[2]), "+v"(o[3]), "+v"(o[4]), "+v"(o[5]), "+v"(o[6]), "+v"(o[7]) :: "memory");
#pragma unroll
            for (int j = 0; j < 8; ++j) *(u32x4*)(GBO + off + (size_t)j * D) = o[j];
        } }
}

__device__ __forceinline__ void final_phase(float* out, const bf16* XH, const bf16* XL, const float* g, int gw, int NGW, int lane) {
    f32x4 gv[4];
#pragma unroll
    for (int j = 0; j < 4; ++j) gv[j] = ((const f32x4*)g)[lane + 64 * j];
    for (int m0 = gw * 4; m0 < M; m0 += NGW * 4) { f32x4 v[4][4]; float rs[4];
#pragma unroll
        for (int q = 0; q < 4; ++q)
#pragma unroll
            for (int j = 0; j < 4; ++j) { const u32x2 h = ((const u32x2*)(XH + (size_t)(m0 + q) * D) + lane)[64 * j], lo = USE_XL ? ((const u32x2*)(XL + (size_t)(m0 + q) * D) + lane)[64 * j] : (u32x2){0u, 0u};
                v[q][j] = (f32x4){pg8::bflo(h.x) + pg8::bflo(lo.x), pg8::bfhi(h.x) + pg8::bfhi(lo.x), pg8::bflo(h.y) + pg8::bflo(lo.y), pg8::bfhi(h.y) + pg8::bfhi(lo.y)}; }
#pragma unroll
        for (int q = 0; q < 4; ++q) { float t = 0.f;
#pragma unroll
            for (int j = 0; j < 4; ++j) t += pg8::dot4(v[q][j]);
            rs[q] = rsqrtf(wave_sum(t) * (1.0f / D) + EPS); }
        asm volatile("" : "+v"(rs[0]), "+v"(rs[1]), "+v"(rs[2]), "+v"(rs[3]) :: "memory");
#pragma unroll
        for (int q = 0; q < 4; ++q)
#pragma unroll
            for (int j = 0; j < 4; ++j) ((f32x4*)(out + (size_t)(m0 + q) * D) + lane)[64 * j] = v[q][j] * rs[q] * gv[j]; }
}

__device__ __forceinline__ void final_phase_f32(float* out, const float* g, int gw, int NGW, int lane) {
    f32x4 gv[4];
#pragma unroll
    for (int j = 0; j < 4; ++j) gv[j] = ((const f32x4*)g)[lane + 64 * j];
    for (int m0 = gw * 4; m0 < M; m0 += NGW * 4) { f32x4 v[4][4]; float rs[4];
#pragma unroll
        for (int q = 0; q < 4; ++q)
#pragma unroll
            for (int j = 0; j < 4; ++j) v[q][j] = ((const f32x4*)(out + (size_t)(m0 + q) * D) + lane)[64 * j];
#pragma unroll
        for (int q = 0; q < 4; ++q) { float t = 0.f;
#pragma unroll
            for (int j = 0; j < 4; ++j) t += pg8::dot4(v[q][j]);
            rs[q] = rsqrtf(wave_sum(t) * (1.0f / D) + EPS); }
        asm volatile("" : "+v"(rs[0]), "+v"(rs[1]), "+v"(rs[2]), "+v"(rs[3]) :: "memory");
#pragma unroll
        for (int q = 0; q < 4; ++q)
#pragma unroll
            for (int j = 0; j < 4; ++j) ((f32x4*)(out + (size_t)(m0 + q) * D) + lane)[64 * j] = v[q][j] * rs[q] * gv[j]; }
}

#ifndef RESID_HILO
#define RESID_HILO 1
#endif
#ifndef PROBE_KIND
#define PROBE_KIND -1
#endif
#ifndef PROBE_SKIP_EPI
#define PROBE_SKIP_EPI 0
#endif
#ifndef EN_MASK
#define EN_MASK 63
#endif
#define EN(k) ((EN_MASK >> (k)) & 1)
constexpr int KPL = 9;
constexpr int N_PHASES = 2 + KPL * DEPTH;

constexpr int RS_OFF = MISC_OFF + 1024;
__device__ __forceinline__ void fill_rstd(LAS unsigned char* lds, const float* PS, int pm, int tid) {
    if (tid < 256) { const float* p = PS + (size_t)(pm * 256 + tid) * 16; const f32x4 a = *(const f32x4*)p, b = *(const f32x4*)(p + 4), c = *(const f32x4*)(p + 8), d = *(const f32x4*)(p + 12);
        ((LAS float*)(lds + RS_OFF))[tid] = rsqrtf(((pg8::sum4(a) + pg8::sum4(b)) + (pg8::sum4(c) + pg8::sum4(d))) * (1.0f / 1024.0f) + EPS); }
    __syncthreads();
}
typedef const __attribute__((address_space(4))) Args* KArgs;
__global__ void __launch_bounds__(NTHREADS, 2) fwd(Args a_unused) {
    extern __shared__ __attribute__((aligned(16))) unsigned char lds_raw[];
    LAS unsigned char* lds = (LAS unsigned char*)lds_raw;
    KArgs kap = (KArgs)__builtin_amdgcn_kernarg_segment_ptr();
    const int ph_lo = kap->ph_lo, ph_hi = kap->ph_hi;
#if MK_XCDBAR
    for (int u = threadIdx.x; u < (LDS_BYTES - MISC_OFF) / 4; u += NTHREADS) ((LAS unsigned*)(lds + MISC_OFF))[u] = 0u;
    __syncthreads();
    XcdBarrier bar = xcd_barrier_post((unsigned*)(kap->ws + WS_CTL) + 4096, (volatile LAS unsigned*)(lds + MISC_OFF) + 8);
#endif
    for (int ph = ph_lo; ph < ph_hi; ++ph) {
        if (ph > ph_lo && !(ph >= 1 && ph < N_PHASES - 1 && (ph - 1) % KPL == 5)) {
#if MK_XCDBAR
            if (ph_hi > 1000) cg::this_grid().sync();
            xcd_barrier(bar);
            if (ph == ph_lo + 1) {
                if (threadIdx.x == 0) { bool uni = gridDim.x == 256; for (unsigned j = 0; j < 16; ++j) { const unsigned c = xb_ld(&bar.bar[XB_XCNT(j)]); uni = uni && (c == (j < 8 ? 32u : 0u)); }
                    bar.st[4] = uni ? (bar.st[2] * 8u + bar.st[3]) : blockIdx.x; }
                __syncthreads(); }
#else
            cg::this_grid().sync();
#endif
        }
        int nrep = 1;
#if PROBE_KIND == 100
        if (ph == 0) nrep = 2;
#elif PROBE_KIND >= 0
        if (ph >= 1 && ph < N_PHASES - 1 && ((ph - 1) % KPL) == PROBE_KIND) nrep = 2;
#endif
        for (int rep = 0; rep < nrep; ++rep) {
#if MK_XCDBAR
        if (rep) xcd_barrier(bar);
#else
        if (rep) cg::this_grid().sync();
#endif
        KArgs ap = kap; asm volatile("" : "+s"(ap));
        int tid = threadIdx.x; asm volatile("" : "+v"(tid));
        const int lane = tid & 63, wave = __builtin_amdgcn_readfirstlane(tid >> 6);
        const int G = gridDim.x, bx = (MK_XCDBAR && ph > ph_lo) ? __builtin_amdgcn_readfirstlane((int)((volatile LAS unsigned*)(lds + MISC_OFF))[12]) : (int)blockIdx.x;
        const int gw = bx * NWAVES + wave, NGW = G * NWAVES;
        unsigned char* ws = ap->ws;
        bf16* XB = (bf16*)(ws + WS_XB); float* PS = (float*)(ws + WS_PS); float* PSV = (float*)(ws + WS_PSV);
        unsigned char* act = ws + WS_ACT;
        bf16* Hb = (bf16*)(act + A_H); bf16* Ub = (bf16*)(act + A_U); bf16* Vb = (bf16*)(act + A_V); bf16* Tb = (bf16*)(act + A_T); bf16* GBb = (bf16*)(act + A_GB); bf16* SAb = (bf16*)(act + A_SA); bf16* SBb = (bf16*)(act + A_SB);
        bf16* G2 = (bf16*)(act + A_V);
        bf16* XLb = (bf16*)(ws + WS_XL);
        const bf16* WB = (const bf16*)(ws + WS_W);
        if (EN(5) && ph == 0) { prologue(ap, lds, gw, NGW, wave, lane); continue; }
#if RESID_HILO
        if (ph == N_PHASES - 1) { final_phase(ap->out, XB, XLb, ap->in[I_FN], gw, NGW, lane); continue; }
#else
        if (ph == N_PHASES - 1) { final_phase_f32(ap->out, ap->in[I_FN], gw, NGW, lane); continue; }
#endif
        const int l = (ph - 1) / KPL, kind = (ph - 1) % KPL;
        const bf16* wl = WB + (size_t)l * E_LAYER;
        if (EN(0) && (kind == 0 || kind == 7)) {
            pg8::Gemm g{XB, wl + (kind == 0 ? O_F1I : O_F2I), M, 2 * FF, D}; pg8::StaticOrder S; S.init(M, 2 * FF, G, bx);
            { pg8::Unit u0; S.next(0, u0); fill_rstd(lds, PS, u0.pm, tid); }
            pg8::EpiFfnUp E{Hb, (const LAS float*)(lds + RS_OFF), PROBE_SKIP_EPI && nrep == 2 && rep == 0};
            pg8::gemm_phase<pg8::EpiFfnUp, pg8::StaticOrder, true, true>(lds, g, S, E);
            if (bx >= 128) {
                const int nw = 128 * NWAVES, wi = (bx - 128) * NWAVES + wave;
                if (kind == 0) convert_layer(ap, lds, l, IT_LAYER / 2, IT_LAYER, wi, nw, wave, lane);
                else if (l + 1 < DEPTH) convert_layer(ap, lds, l + 1, 0, IT_LAYER / 2, wi, nw, wave, lane); }
        } else if (EN(1) && (kind == 1 || kind == 8 || kind == 6)) {
            const bool ffn = kind != 6;
            pg8::Gemm g{ffn ? Hb : (GATE2048 ? G2 : SAb), wl + (kind == 1 ? O_F1O : (kind == 8 ? O_F2O : O_WO)), M, D, ffn ? FF : (GATE2048 ? 2 * D : D)}; pg8::StaticOrder S; S.init(M, D, G, bx);
#if RESID_HILO
            pg8::EpiResid E{XB, XLb, PS, ffn ? 0.5f : 1.0f, ffn ? 2.0f : 1.0f};
            pg8::gemm_phase<pg8::EpiResid, pg8::StaticOrder, true, true>(lds, g, S, E);
#else
            pg8::EpiResidF32 E{(l == 0 && kind == 1) ? ap->in[I_X] : ap->out, ap->out, XB, PS, ffn ? 0.5f : 1.0f, ffn ? 2.0f : 1.0f};
            pg8::gemm_phase<pg8::EpiResidF32, pg8::StaticOrder, true, true>(lds, g, S, E);
#endif
        } else if (EN(2) && kind == 2) {
            pg8::Gemm g{XB, wl + O_WIN, M, NIN, D}; pg8::StaticOrder S; S.init(M, NIN, G, bx);
            { pg8::Unit u0; S.next(0, u0); fill_rstd(lds, PS, u0.pm, tid); }
            pg8::EpiMixIn E{Ub, Vb, Tb, GBb, SAb, SBb, (const LAS float*)(lds + RS_OFF), PSV};
            pg8::gemm_phase<pg8::EpiMixIn, pg8::StaticOrder, true, true>(lds, g, S, E);
        } else if (EN(3) && kind == 3) {
            if ((bx >> 3) & 1) {
                conv_phase(GBb, (nrep == 2 && rep == 0) ? (bf16*)(ws + WS_END) : GBb, Tb, ap->in[I_CW] + (size_t)l * 3 * D, bx * NTHREADS + tid, G * NTHREADS);
                sgu_phase(lds, bx, G, Ub, (nrep == 2 && rep == 0) ? (bf16*)(ws + WS_END) : Ub, Vb, PSV, ap->in[I_SGW] + (size_t)l * HEADS * CHUNK * CHUNK, ap->in[I_SGB] + (size_t)l * HEADS * CHUNK, ap->in[I_SGN] + (size_t)l * D, tid);
            } else {
                sgu_phase(lds, bx, G, Ub, (nrep == 2 && rep == 0) ? (bf16*)(ws + WS_END) : Ub, Vb, PSV, ap->in[I_SGW] + (size_t)l * HEADS * CHUNK * CHUNK, ap->in[I_SGB] + (size_t)l * HEADS * CHUNK, ap->in[I_SGN] + (size_t)l * D, tid);
                conv_phase(GBb, (nrep == 2 && rep == 0) ? (bf16*)(ws + WS_END) : GBb, Tb, ap->in[I_CW] + (size_t)l * 3 * D, bx * NTHREADS + tid, G * NTHREADS);
            }
        } else if (EN(4) && kind == 4) {
            pg8::StaticOrder S; S.init(M, D, G, bx);
            pg8::Gemm g{Ub, wl + O_PA, M, D, 2 * D, GBb, wl + O_PB, D / pg8::BK, D, D}; pg8::EpiMerge E{SAb, SBb, SAb};
            pg8::gemm_phase<pg8::EpiMerge, pg8::StaticOrder, true, true>(lds, g, S, E);
        }
        }
    }
}

extern "C" void kernel_launch(void* const* d_in, const int* in_sizes, int n_in, void* d_out, int out_size, void* d_ws, size_t ws_size, hipStream_t stream) {
    static int state = 0;
    if (state == 0) {
        if (n_in != 17 || in_sizes[0] != M * D || out_size != M * D || ws_size < WS_END + (PROBE_KIND == 3 ? 32 * MiB : 0)) { fprintf(stderr, "kernel_launch: unexpected shapes (n_in %d, in0 %d, out %d, ws %zu < %zu)\n", n_in, n_in > 0 ? in_sizes[0] : -1, out_size, ws_size, (size_t)WS_END); state = -1; return; }
        if (hipFuncSetAttribute((const void*)fwd, hipFuncAttributeMaxDynamicSharedMemorySize, LDS_BYTES) != hipSuccess) { fprintf(stderr, "kernel_launch: hipFuncSetAttribute failed\n"); state = -1; return; }
        state = 1;
    }
    if (state < 0) return;
    (void)hipMemsetAsync((char*)d_ws + WS_CTL + 16384, 0, 16384, stream);
    Args a{};
    for (int i = 0; i < 17; ++i) a.in[i] = (const float*)d_in[i];
    a.out = (float*)d_out; a.ws = (unsigned char*)d_ws;
#if MK_SINGLE
    a.ph_lo = 0; a.ph_hi = N_PHASES;
    void* params[] = {&a};
    hipError_t e = hipLaunchCooperativeKernel((const void*)fwd, dim3(256), dim3(NTHREADS), params, LDS_BYTES, stream);
    if (e != hipSuccess) fprintf(stderr, "kernel_launch: cooperative launch failed: %s\n", hipGetErrorString(e));
#else
    for (int ph = 0; ph < N_PHASES; ++ph) { a.ph_lo = ph; a.ph_hi = ph + 1; hipLaunchKernelGGL(fwd, dim3(256), dim3(NTHREADS), LDS_BYTES, stream, a); }
#endif
}
```

```cpp
#include <hip/hip_runtime.h>
#include <hip/hip_cooperative_groups.h>
#include <cstdio>
#include <cstdint>
namespace cg = cooperative_groups;

#ifndef MK_SINGLE
#define MK_SINGLE 1
#endif
#ifndef MK_XCDBAR
#define MK_XCDBAR 1
#endif

constexpr int BATCH = 8, SEQ = 2048, D = 1024, DEPTH = 4, FF = 2816, NIN = 7168, CHUNK = 128, HEADS = 8;
constexpr int M = BATCH * SEQ;
constexpr float EPS = 1e-6f;
constexpr bool USE_XL = false;

namespace pg8 {
#define PG8_LAS __attribute__((address_space(3)))
typedef unsigned short bf16_t;
typedef short bf16x8 __attribute__((ext_vector_type(8)));
typedef float f32x4 __attribute__((ext_vector_type(4)));
typedef unsigned u32x4 __attribute__((ext_vector_type(4)));
constexpr int BM = 256, BK = 64, HALF = 128, HTB = HALF * BK * 2  , STAGE_BYTES = 8 * HTB, NXCD = 8, WGM = 8;

__host__ __device__ __forceinline__ int lds_byte(int r, int c) { const int st = (r >> 4) * 2 + (c >> 5), rr = r & 15, cc = c & 31, ob = rr * 64 + cc * 2; return st * 1024 + (ob ^ (((ob >> 9) & 1) << 5)); }
__host__ __device__ __forceinline__ void stage_rc(int b, int& R, int& C) { const int st = b / 1024, sb = b % 1024, swz = sb ^ (((sb >> 9) & 1) << 5); R = (st >> 1) * 16 + swz / 64; C = (st & 1) * 32 + (swz % 64) / 2; }
__host__ __device__ __forceinline__ int perm32(int rho) { const int n = rho >> 4, i = rho & 15; return 8 * (i >> 2) + 4 * n + (i & 3); }

struct Unit { int pm, pn; };
struct Gemm { const bf16_t* A; const bf16_t* Bt; int M, N, K; const bf16_t* A2; const bf16_t* Bt2; int ksplit, lda, ldb; };

struct StaticOrder {
    int nM, nN, nwg, G, c;
    __host__ __device__ void init(int M, int N, int G_, int c_) { nM = M / BM; nN = N / BM; nwg = nM * nN; G = G_; c = c_; }
    __host__ __device__ bool next(int i, Unit& u) const {
        if (nM == 64 && G == 256) {
            u.pm = 8 * (c & 7) + ((c >> 3) & 7); u.pn = 4 * i + (c >> 6); return u.pn < nN; }
        const long L = (long)i * G + c; if (L >= nwg) return false;
        int wgid = (int)L; { const int q = nwg / NXCD, r = nwg % NXCD, xcd = wgid % NXCD, off = wgid / NXCD; wgid = (xcd < r ? xcd * (q + 1) : r * (q + 1) + (xcd - r) * q) + off; }
        const int nig = WGM * nN, gid = wgid / nig, fm = gid * WGM, gsz = (nM - fm) < WGM ? (nM - fm) : WGM;
        u.pm = fm + ((wgid % nig) % gsz); u.pn = (wgid % nig) / gsz; return true;
    }
    __device__ __forceinline__ void a_ready(const Unit&) const {}
    __device__ __forceinline__ void done(const Unit&) const {}
};
typedef _Float16 h2_t __attribute__((ext_vector_type(2))); typedef _Float16 h8_t __attribute__((ext_vector_type(8)));
__device__ __forceinline__ unsigned cvt_pk_bf16(float lo, float hi) { unsigned r; asm volatile("v_cvt_pk_bf16_f32 %0, %1, %2" : "=v"(r) : "v"(lo), "v"(hi)); return r; }
typedef unsigned u32x2 __attribute__((ext_vector_type(2)));
__device__ __forceinline__ float fsigmoid(float x) { return __builtin_amdgcn_rcpf(1.0f + __builtin_amdgcn_exp2f(-1.44269504089f * x)); }
__device__ __forceinline__ float fsilu(float x) { return x * fsigmoid(x); }
__device__ __forceinline__ float fgelu(float x) { return x * fsigmoid(1.59576912161f * (x + 0.044715f * x * x * x)); }
__device__ __forceinline__ f32x4 vexp2(const f32x4 t) { return (f32x4){__builtin_amdgcn_exp2f(t[0]), __builtin_amdgcn_exp2f(t[1]), __builtin_amdgcn_exp2f(t[2]), __builtin_amdgcn_exp2f(t[3])}; }
__device__ __forceinline__ f32x4 vrcp(const f32x4 t) { return (f32x4){__builtin_amdgcn_rcpf(t[0]), __builtin_amdgcn_rcpf(t[1]), __builtin_amdgcn_rcpf(t[2]), __builtin_amdgcn_rcpf(t[3])}; }
__device__ __forceinline__ f32x4 vsig_from_t(const f32x4 t) { return vrcp(vexp2(t) + 1.0f); }
__device__ __forceinline__ f32x4 vgelu(const f32x4 x) { const f32x4 w = (x * x) * (-0.10294324f) + (-2.30220819f); return x * vsig_from_t(w * x); }
typedef __amdgpu_buffer_rsrc_t rsrc_t;
__device__ __forceinline__ rsrc_t mk_rsrc(const void* p, size_t bytes) { return __builtin_amdgcn_make_buffer_rsrc((void*)p, 0, (int)bytes, 0x00020000); }
__device__ __forceinline__ void st16_wt(const rsrc_t r, size_t byte_off, const u32x4 v) { __builtin_amdgcn_raw_buffer_store_b128(v, r, (unsigned)byte_off, 0,   16); }
__device__ __forceinline__ u32x4 ld16_b(const rsrc_t r, unsigned voff, unsigned soff) { return __builtin_amdgcn_raw_buffer_load_b128(r, voff, soff, 0); }
__device__ __forceinline__ float bflo(unsigned w) { return __uint_as_float(w << 16); }
__device__ __forceinline__ float bfhi(unsigned w) { return __uint_as_float(w & 0xffff0000u); }
__device__ __forceinline__ u32x4 pack8(const f32x4 a, const f32x4 b) { u32x4 w; w.x = cvt_pk_bf16(a[0], a[1]); w.y = cvt_pk_bf16(a[2], a[3]); w.z = cvt_pk_bf16(b[0], b[1]); w.w = cvt_pk_bf16(b[2], b[3]); return w; }
__device__ __forceinline__ void unpack8(const u32x4 w, f32x4& a, f32x4& b) { a = (f32x4){bflo(w.x), bfhi(w.x), bflo(w.y), bfhi(w.y)}; b = (f32x4){bflo(w.z), bfhi(w.z), bflo(w.w), bfhi(w.w)}; }
__device__ __forceinline__ float sum4(const f32x4 v) { return (v[0] + v[1]) + (v[2] + v[3]); }
__device__ __forceinline__ float dot4(const f32x4 v) { return (v[0] * v[0] + v[1] * v[1]) + (v[2] * v[2] + v[3] * v[3]); }
__device__ __forceinline__ float row_rstd(const float* PS, int row, int fq) {
    float s = sum4(*(const f32x4*)(PS + (size_t)row * 16 + 4 * fq)); s += __shfl_xor(s, 16); s += __shfl_xor(s, 32);
    return rsqrtf(s * (1.0f / 1024.0f) + EPS);
}

#define PIN8(a) asm volatile("" : "+v"(a[0][0]), "+v"(a[0][1]), "+v"(a[0][2]), "+v"(a[0][3]), "+v"(a[1][0]), "+v"(a[1][1]), "+v"(a[1][2]), "+v"(a[1][3]) :: "memory")
#define PIN16(a) asm volatile("" : "+v"(a[0][0][0]), "+v"(a[0][0][1]), "+v"(a[0][1][0]), "+v"(a[0][1][1]), "+v"(a[0][2][0]), "+v"(a[0][2][1]), "+v"(a[0][3][0]), "+v"(a[0][3][1]), \
                                    "+v"(a[1][0][0]), "+v"(a[1][0][1]), "+v"(a[1][1][0]), "+v"(a[1][1][1]), "+v"(a[1][2][0]), "+v"(a[1][2][1]), "+v"(a[1][3][0]), "+v"(a[1][3][1]) :: "memory")
__device__ __forceinline__ void rows_rstd(const PG8_LAS float* RS, int wr, int fr, float (&rs)[2][4]) {
#pragma unroll
    for (int ai = 0; ai < 2; ++ai)
#pragma unroll
        for (int m = 0; m < 4; ++m) rs[ai][m] = RS[wr * 64 + ai * HALF + m * 16 + fr];
}

struct EpiFfnUp {
    static constexpr bool PERM = true, AFTER_DRAIN = false, INIT_ACC = false, HAS_MID = false;
    bf16_t* H; const PG8_LAS float* RS; bool skip;
    __device__ __forceinline__ void operator()(const f32x4 (&acc)[2][2][4][2], const Unit& u, int wr, int wc, int fr, int fq) const {
        const int row0 = u.pm * BM + wr * 64 + fr, col0 = u.pn * 128 + wc * 32 + 8 * fq;
        if (skip) { if (acc[0][0][0][0][0] == 123.456f) H[row0] = 0; return; }
        float rs[2][4]; rows_rstd(RS, wr, fr, rs);
        const rsrc_t rH = mk_rsrc(H, (size_t)M * FF * 2);
#pragma unroll
        for (int ai = 0; ai < 2; ++ai)
#pragma unroll
            for (int m = 0; m < 4; ++m) { const int row = row0 + ai * HALF + m * 16; const float r = rs[ai][m];
                const float c = -1.44269504089f * r, r2 = r * r;
                const f32x4 h0 = (acc[ai][0][m][0] * acc[ai][1][m][0]) * (vsig_from_t(acc[ai][0][m][0] * c) * r2), h1 = (acc[ai][0][m][1] * acc[ai][1][m][1]) * (vsig_from_t(acc[ai][0][m][1] * c) * r2);
                st16_wt(rH, ((size_t)row * FF + col0) * 2, pack8(h0, h1)); }
    }
};
struct EpiResid {
    static constexpr bool PERM = true, AFTER_DRAIN = false, INIT_ACC = true, HAS_MID = false;
    bf16_t* XH; bf16_t* XL; float* PS; float scale, inv_scale;
    __device__ __forceinline__ void init(f32x4 (&acc)[2][2][4][2], const Unit& u, int wr, int wc, int fr, int fq) const {
        const int row0 = u.pm * BM + wr * 64 + fr, col0 = u.pn * BM + wc * 32 + 8 * fq;
#pragma unroll
        for (int ai = 0; ai < 2; ++ai)
#pragma unroll
            for (int m = 0; m < 4; ++m)
#pragma unroll
                for (int bj = 0; bj < 2; ++bj) { const size_t off = (size_t)(row0 + ai * HALF + m * 16) * D + col0 + bj * HALF;
                    f32x4 h0, h1, l0 = (f32x4){0.f, 0.f, 0.f, 0.f}, l1 = l0; unpack8(*(const u32x4*)(XH + off), h0, h1); if (USE_XL) unpack8(*(const u32x4*)(XL + off), l0, l1);
                    acc[ai][bj][m][0] = (h0 + l0) * inv_scale; acc[ai][bj][m][1] = (h1 + l1) * inv_scale; }
    }
    __device__ __forceinline__ void operator()(const f32x4 (&acc)[2][2][4][2], const Unit& u, int wr, int wc, int fr, int fq) const {
        const int row0 = u.pm * BM + wr * 64 + fr, col0 = u.pn * BM + wc * 32 + 8 * fq;
        const rsrc_t rXH = mk_rsrc(XH, (size_t)M * D * 2), rXL = mk_rsrc(XL, (size_t)M * D * 2);
#pragma unroll
        for (int ai = 0; ai < 2; ++ai)
#pragma unroll
            for (int m = 0; m < 4; ++m) { const int row = row0 + ai * HALF + m * 16; float ss = 0.f;
#pragma unroll
                for (int bj = 0; bj < 2; ++bj) { const size_t off = (size_t)row * D + col0 + bj * HALF;
                    const f32x4 a = acc[ai][bj][m][0] * scale, b = acc[ai][bj][m][1] * scale; ss += dot4(a) + dot4(b);
                    const u32x4 hi = pack8(a, b); f32x4 ha, hb; unpack8(hi, ha, hb);
                    st16_wt(rXH, off * 2, hi); if (USE_XL) st16_wt(rXL, off * 2, pack8(a - ha, b - hb)); }
                ss += __shfl_xor(ss, 16); ss += __shfl_xor(ss, 32);
                if (fq == 0) PS[(size_t)row * 16 + u.pn * 4 + wc] = ss; }
    }
};
struct EpiResidF32 {
    static constexpr bool PERM = true, AFTER_DRAIN = false, INIT_ACC = true, HAS_MID = false;
    const float* xs; float* xd; bf16_t* XB; float* PS; float scale, inv_scale;
    __device__ __forceinline__ void init(f32x4 (&acc)[2][2][4][2], const Unit& u, int wr, int wc, int fr, int fq) const {
        const int row0 = u.pm * BM + wr * 64 + fr, col0 = u.pn * BM + wc * 32 + 8 * fq;
#pragma unroll
        for (int ai = 0; ai < 2; ++ai)
#pragma unroll
            for (int m = 0; m < 4; ++m)
#pragma unroll
                for (int bj = 0; bj < 2; ++bj) { const size_t off = (size_t)(row0 + ai * HALF + m * 16) * D + col0 + bj * HALF;
                    acc[ai][bj][m][0] = *(const f32x4*)(xs + off) * inv_scale; acc[ai][bj][m][1] = *(const f32x4*)(xs + off + 4) * inv_scale; }
    }
    __device__ __forceinline__ void operator()(const f32x4 (&acc)[2][2][4][2], const Unit& u, int wr, int wc, int fr, int fq) const {
        const int row0 = u.pm * BM + wr * 64 + fr, col0 = u.pn * BM + wc * 32 + 8 * fq;
#pragma unroll
        for (int ai = 0; ai < 2; ++ai)
#pragma unroll
            for (int m = 0; m < 4; ++m) { const int row = row0 + ai * HALF + m * 16; float ss = 0.f;
#pragma unroll
                for (int bj = 0; bj < 2; ++bj) { const size_t off = (size_t)row * D + col0 + bj * HALF;
                    const f32x4 a = acc[ai][bj][m][0] * scale, b = acc[ai][bj][m][1] * scale;
                    *(f32x4*)(xd + off) = a; *(f32x4*)(xd + off + 4) = b; ss += dot4(a) + dot4(b);
                    *(u32x4*)(XB + off) = pack8(a, b); }
                ss += __shfl_xor(ss, 16); ss += __shfl_xor(ss, 32);
                if (fq == 0) PS[(size_t)row * 16 + u.pn * 4 + wc] = ss; }
    }
};
struct EpiMixIn {
    static constexpr bool PERM = true, AFTER_DRAIN = false, INIT_ACC = false, HAS_MID = false;
    bf16_t *U, *V, *T, *GB, *SA, *SB; const PG8_LAS float* RS; float* PSV;
    __device__ __forceinline__ void operator()(const f32x4 (&acc)[2][2][4][2], const Unit& u, int wr, int wc, int fr, int fq) const {
        const int pn = u.pn, row0 = u.pm * BM + wr * 64 + fr, cw = wc * 32 + 8 * fq;
        float rs[2][4]; rows_rstd(RS, wr, fr, rs);
        if (pn >= 12 && pn < 20) {
            const int col = (pn - 12) * 128 + cw; const rsrc_t rT = mk_rsrc(T, (size_t)M * D * 2);
#pragma unroll
            for (int ai = 0; ai < 2; ++ai)
#pragma unroll
                for (int m = 0; m < 4; ++m) { const int row = row0 + ai * HALF + m * 16; const float r2 = rs[ai][m] * rs[ai][m];
                    const f32x4 t0 = acc[ai][0][m][0] * acc[ai][1][m][0] * r2, t1 = acc[ai][0][m][1] * acc[ai][1][m][1] * r2;
                    st16_wt(rT, ((size_t)row * D + col) * 2, pack8(t0, t1)); }
        } else {
            bf16_t* O; int cb, act;
            if (pn < 4) { O = U; cb = pn * 256; act = 1; } else if (pn < 8) { O = V; cb = (pn - 4) * 256; act = 2; } else if (pn < 12) { O = GB; cb = (pn - 8) * 256; act = 0; }
            else if (pn < 24) { O = SA; cb = (pn - 20) * 256; act = 3; } else { O = SB; cb = (pn - 24) * 256; act = 3; }
            const rsrc_t rO = mk_rsrc(O, (size_t)M * D * 2);
#pragma unroll
            for (int ai = 0; ai < 2; ++ai)
#pragma unroll
                for (int m = 0; m < 4; ++m) { const int row = row0 + ai * HALF + m * 16; const float r = rs[ai][m]; float ss = 0.f;
#pragma unroll
                    for (int bj = 0; bj < 2; ++bj) { f32x4 v0 = acc[ai][bj][m][0] * r, v1 = acc[ai][bj][m][1] * r;
                        if (act == 1 || act == 2) { v0 = vgelu(v0); v1 = vgelu(v1); ss += dot4(v0) + dot4(v1); }
                        else if (act == 3) { v0 = vsig_from_t(v0 * (-1.44269504089f)); v1 = vsig_from_t(v1 * (-1.44269504089f)); }
                        st16_wt(rO, ((size_t)row * D + cb + bj * HALF + cw) * 2, pack8(v0, v1)); }
                    if (act == 2) { ss += __shfl_xor(ss, 16); ss += __shfl_xor(ss, 32); if (fq == 0) PSV[(size_t)row * 16 + (pn - 4) * 4 + wc] = ss; } }
        }
    }
};
struct EpiGate {
    static constexpr bool PERM = true, AFTER_DRAIN = false, INIT_ACC = false, HAS_MID = false;
    const bf16_t* GATE; bf16_t* O; int coff;
    __device__ __forceinline__ void operator()(const f32x4 (&acc)[2][2][4][2], const Unit& u, int wr, int wc, int fr, int fq) const {
        const int row0 = u.pm * BM + wr * 64 + fr, col0 = u.pn * BM + wc * 32 + 8 * fq;
        u32x4 g[2][4][2];
#pragma unroll
        for (int ai = 0; ai < 2; ++ai)
#pragma unroll
            for (int m = 0; m < 4; ++m)
#pragma unroll
                for (int bj = 0; bj < 2; ++bj) g[ai][m][bj] = *(const u32x4*)(GATE + (size_t)(row0 + ai * HALF + m * 16) * D + col0 + bj * HALF);
        PIN16(g);
#pragma unroll
        for (int ai = 0; ai < 2; ++ai)
#pragma unroll
            for (int m = 0; m < 4; ++m)
#pragma unroll
                for (int bj = 0; bj < 2; ++bj) { f32x4 g0, g1; unpack8(g[ai][m][bj], g0, g1);
                    *(u32x4*)(O + (size_t)(row0 + ai * HALF + m * 16) * (2 * D) + coff + col0 + bj * HALF) = pack8(g0 * acc[ai][bj][m][0], g1 * acc[ai][bj][m][1]); }
    }
};

struct EpiProj {
    static constexpr bool PERM = true, AFTER_DRAIN = false, INIT_ACC = false, HAS_MID = false;
    const bf16_t* GATE; bf16_t* ST; bf16_t* MG; bool second;
    __device__ __forceinline__ void operator()(const f32x4 (&acc)[2][2][4][2], const Unit& u, int wr, int wc, int fr, int fq) const {
        const int row0 = u.pm * BM + wr * 64 + fr, col0 = u.pn * BM + wc * 32 + 8 * fq;
        u32x4 w[2][4][2];
#pragma unroll
        for (int ai = 0; ai < 2; ++ai) {
            u32x4 g[4][2], p[4][2];
#pragma unroll
            for (int m = 0; m < 4; ++m)
#pragma unroll
                for (int bj = 0; bj < 2; ++bj) { const size_t off = (size_t)(row0 + ai * HALF + m * 16) * D + col0 + bj * HALF;
                    g[m][bj] = *(const u32x4*)(GATE + off); p[m][bj] = second ? *(const u32x4*)(ST + off) : (u32x4){0u, 0u, 0u, 0u}; }
#pragma unroll
            for (int m = 0; m < 4; ++m)
#pragma unroll
                for (int bj = 0; bj < 2; ++bj) { f32x4 g0, g1, p0, p1; unpack8(g[m][bj], g0, g1); unpack8(p[m][bj], p0, p1);
                    w[ai][m][bj] = pack8(p0 + g0 * acc[ai][bj][m][0], p1 + g1 * acc[ai][bj][m][1]); }
            asm volatile("" ::: "memory");
        }
        PIN16(w);
        const rsrc_t rO = mk_rsrc(second ? MG : ST, (size_t)M * D * 2);
#pragma unroll
        for (int ai = 0; ai < 2; ++ai)
#pragma unroll
            for (int m = 0; m < 4; ++m)
#pragma unroll
                for (int bj = 0; bj < 2; ++bj) st16_wt(rO, ((size_t)(row0 + ai * HALF + m * 16) * D + col0 + bj * HALF) * 2, w[ai][m][bj]);
    }
};

struct EpiMerge {
    static constexpr bool PERM = true, AFTER_DRAIN = false, INIT_ACC = false, HAS_MID = true;
    const bf16_t* SA; const bf16_t* SB; bf16_t* MG;
    __device__ __forceinline__ void mid(f32x4 (&acc)[2][2][4][2], const Unit& u, int wr, int wc, int fr, int fq) const {
        const int row0 = u.pm * BM + wr * 64 + fr, col0 = u.pn * BM + wc * 32 + 8 * fq;
        const rsrc_t rA = mk_rsrc(SA, (size_t)M * D * 2), rB = mk_rsrc(SB, (size_t)M * D * 2);
        const unsigned voff = (unsigned)((size_t)row0 * D + col0) * 2u;
#pragma unroll
        for (int ai = 0; ai < 2; ++ai) {
            u32x4 ga[4][2], gb[4][2];
#pragma unroll
            for (int m = 0; m < 4; ++m)
#pragma unroll
                for (int bj = 0; bj < 2; ++bj) { const unsigned so = (unsigned)(((ai * HALF + m * 16) * D + bj * HALF) * 2); ga[m][bj] = ld16_b(rA, voff, so); gb[m][bj] = ld16_b(rB, voff, so); }
#pragma unroll
            for (int m = 0; m < 4; ++m)
#pragma unroll
                for (int bj = 0; bj < 2; ++bj) { f32x4 a0, a1, b0, b1; unpack8(ga[m][bj], a0, a1); unpack8(gb[m][bj], b0, b1);
                    acc[ai][bj][m][0] = acc[ai][bj][m][0] * (a0 * vrcp(b0)); acc[ai][bj][m][1] = acc[ai][bj][m][1] * (a1 * vrcp(b1)); }
            asm volatile("" ::: "memory"); }
    }
    __device__ __forceinline__ void operator()(const f32x4 (&acc)[2][2][4][2], const Unit& u, int wr, int wc, int fr, int fq) const {
        const int row0 = u.pm * BM + wr * 64 + fr, col0 = u.pn * BM + wc * 32 + 8 * fq;
        u32x4 g[2][4][2];
#pragma unroll
        for (int ai = 0; ai < 2; ++ai)
#pragma unroll
            for (int m = 0; m < 4; ++m)
#pragma unroll
                for (int bj = 0; bj < 2; ++bj) g[ai][m][bj] = *(const u32x4*)(SB + (size_t)(row0 + ai * HALF + m * 16) * D + col0 + bj * HALF);
        PIN16(g);
        const rsrc_t rO = mk_rsrc(MG, (size_t)M * D * 2);
#pragma unroll
        for (int ai = 0; ai < 2; ++ai)
#pragma unroll
            for (int m = 0; m < 4; ++m)
#pragma unroll
                for (int bj = 0; bj < 2; ++bj) { f32x4 b0, b1; unpack8(g[ai][m][bj], b0, b1);
                    st16_wt(rO, ((size_t)(row0 + ai * HALF + m * 16) * D + col0 + bj * HALF) * 2, pack8(b0 * acc[ai][bj][m][0], b1 * acc[ai][bj][m][1])); }
    }
};

template <class Epi, class Sched, bool ALIGN_EPI = false, bool SP2 = false>
__device__ __forceinline__ void gemm_phase(PG8_LAS unsigned char* lds, const Gemm g, const Sched& S, const Epi& E) {
    int tid_ = threadIdx.x; asm volatile("" : "+v"(tid_));
    const int tid = tid_, wid = __builtin_amdgcn_readfirstlane(tid >> 6), lane = tid & 63, wr = wid >> 2, wc = wid & 3, fr = lane & 15, fq = lane >> 4;
    const int K = g.K, nt = K / BK, lda = g.lda ? g.lda : K, ldb = g.ldb ? g.ldb : K, ks = g.ksplit;
    unsigned voffA[2], voffB[2];
#pragma unroll
    for (int i = 0; i < 2; ++i) { int R, C; stage_rc(tid * 16 + i * 8192, R, C); const int Rb = Epi::PERM ? ((R & ~31) + perm32(R & 31)) : R;
        voffA[i] = (unsigned)(R * lda + C) * 2u; voffB[i] = (unsigned)(Rb * ldb + C) * 2u; }
    const size_t kstep = (size_t)(BK * 2);
    const size_t hstepA = (size_t)HALF * lda * 2, hstepB = (size_t)HALF * ldb * 2;
    const size_t tstepA = 2 * hstepA, tstepB = 2 * hstepB;
    const unsigned ldsw = (unsigned)wid * 1024u;
    const int aoff = lds_byte(wr * 64 + fr, fq * 8), boff = lds_byte(wc * 32 + fr, fq * 8);
#define PG8_SA(b, h) (((b) * 2 + (h)) * HTB)
#define PG8_SB(b, h) ((4 + (b) * 2 + (h)) * HTB)
#define PG8_STAGE(bufoff, gbase, voff) do { _Pragma("unroll") for (int _i = 0; _i < 2; ++_i) \
        __builtin_amdgcn_global_load_lds((const unsigned*)((const char*)(gbase) + (voff)[_i]), (PG8_LAS unsigned*)(lds + (bufoff) + ldsw + _i * 8192), 16, 0, 0); } while (0)
#define PG8_LDA(dst, b, h) do { _Pragma("unroll") for (int m = 0; m < 4; ++m) _Pragma("unroll") for (int k = 0; k < 2; ++k) dst[m][k] = *(const PG8_LAS bf16x8*)(lds + PG8_SA(b, h) + aoff + m * 2048 + k * 1024); } while (0)
#define PG8_LDB(dst, b, h) do { _Pragma("unroll") for (int n = 0; n < 2; ++n) _Pragma("unroll") for (int k = 0; k < 2; ++k) dst[n][k] = *(const PG8_LAS bf16x8*)(lds + PG8_SB(b, h) + boff + n * 2048 + k * 1024); } while (0)
#define PG8_MMA(ai, bj, At, Bt) do { __builtin_amdgcn_s_setprio(1); _Pragma("unroll") for (int m = 0; m < 4; ++m) _Pragma("unroll") for (int n = 0; n < 2; ++n) _Pragma("unroll") for (int k = 0; k < 2; ++k) \
        acc[ai][bj][m][n] = __builtin_amdgcn_mfma_f32_16x16x32_bf16(Bt[n][k], At[m][k], acc[ai][bj][m][n], 0, 0, 0); __builtin_amdgcn_s_setprio(0); } while (0)
#define PG8_WAIT_V(n) asm volatile("s_waitcnt vmcnt(" #n ")" ::: "memory")
#define PG8_WAIT_L(n) asm volatile("s_waitcnt lgkmcnt(" #n ")" ::: "memory")
#define PG8_BAR __builtin_amdgcn_s_barrier()
#define PG8_SCHED __builtin_amdgcn_sched_barrier(0)
    Unit cur, nxt; int ui = 0;
    if (!S.next(0, cur)) return;
    f32x4 acc[2][2][4][2];
#pragma unroll
    for (int a = 0; a < 2; ++a)
#pragma unroll
        for (int b = 0; b < 2; ++b)
#pragma unroll
            for (int m = 0; m < 4; ++m)
#pragma unroll
                for (int n = 0; n < 2; ++n) acc[a][b][m][n] = (f32x4){0.f, 0.f, 0.f, 0.f};
    if constexpr (Epi::INIT_ACC) E.init(acc, cur, wr, wc, fr, fq);
    bf16x8 At[4][2], B0[2][2], B1[2][2];
    const char* cA = (const char*)g.A + (size_t)cur.pm * tstepA; const char* cB = (const char*)g.Bt + (size_t)cur.pn * tstepB;
    S.a_ready(cur);
    if constexpr (SP2) {
        PG8_STAGE(PG8_SB(0, 0), cB, voffB); PG8_STAGE(PG8_SB(0, 1), cB + hstepB, voffB); PG8_STAGE(PG8_SA(0, 0), cA, voffA); PG8_STAGE(PG8_SA(0, 1), cA + hstepA, voffA);
        if (wr == 1) PG8_BAR;
        PG8_WAIT_V(2); PG8_BAR;
        PG8_STAGE(PG8_SB(1, 0), cB + kstep, voffB); PG8_STAGE(PG8_SA(1, 0), cA + kstep, voffA); PG8_STAGE(PG8_SB(1, 1), cB + hstepB + kstep, voffB);
        PG8_WAIT_V(6); PG8_BAR;
    } else {
        PG8_STAGE(PG8_SB(0, 0), cB, voffB); PG8_STAGE(PG8_SA(0, 0), cA, voffA); PG8_STAGE(PG8_SB(0, 1), cB + hstepB, voffB); PG8_STAGE(PG8_SA(0, 1), cA + hstepA, voffA);
        if (wr == 1) PG8_BAR;
        PG8_WAIT_V(4); PG8_BAR;
        PG8_STAGE(PG8_SB(1, 0), cB + kstep, voffB); PG8_STAGE(PG8_SA(1, 0), cA + kstep, voffA); PG8_STAGE(PG8_SB(1, 1), cB + hstepB + kstep, voffB);
        PG8_WAIT_V(6); PG8_BAR;
    }
    for (;;) {
        const bool has_next = S.next(ui + 1, nxt);
        const char* nA = has_next ? (const char*)g.A + (size_t)nxt.pm * tstepA : cA; const char* nB = has_next ? (const char*)g.Bt + (size_t)nxt.pn * tstepB : cB;
        const char* cA2 = (const char*)g.A2 + (size_t)cur.pm * tstepA; const char* cB2 = (const char*)g.Bt2 + (size_t)cur.pn * tstepB;
        const int tsplit = (Epi::HAS_MID && ks) ? ks : nt;
        for (int seg = 0, t0 = 0; t0 < nt; ++seg) { const int t1 = (seg == 0) ? tsplit : nt;
        if constexpr (Epi::HAS_MID) { if (seg) E.mid(acc, cur, wr, wc, fr, fq); }
        for (int t = t0; t < t1; t += 2) {
            const bool last = (t == nt - 2);
            const bool s1 = ks && (t + 1 >= ks), s2 = ks && (t + 2 >= ks);
            const char* a1 = s1 ? cA2 + (size_t)(t + 1 - ks) * kstep : cA + (size_t)(t + 1) * kstep;
            const char* a2 = last ? nA : (s2 ? cA2 + (size_t)(t + 2 - ks) * kstep : cA + (size_t)(t + 2) * kstep); const char* b2 = last ? nB : (s2 ? cB2 + (size_t)(t + 2 - ks) * kstep : cB + (size_t)(t + 2) * kstep);
            const char* a3 = a2 + kstep; const char* b3 = b2 + kstep;
            if (last && has_next) S.a_ready(nxt);
            if constexpr (SP2) {
            PG8_LDB(B0, 0, 0); PG8_LDB(B1, 0, 1); PG8_SCHED; PG8_LDA(At, 0, 0); PG8_STAGE(PG8_SA(1, 1), a1 + hstepA, voffA);
            PG8_WAIT_V(8); PG8_WAIT_L(0); PG8_BAR; PG8_MMA(0, 0, At, B0); PG8_MMA(0, 1, At, B1); PG8_BAR; PG8_SCHED;
            PG8_LDA(At, 0, 1); PG8_STAGE(PG8_SB(0, 0), b2, voffB); PG8_STAGE(PG8_SB(0, 1), b2 + hstepB, voffB); PG8_STAGE(PG8_SA(0, 0), a2, voffA);
            PG8_WAIT_V(8); PG8_WAIT_L(0); PG8_BAR; PG8_MMA(1, 0, At, B0); PG8_MMA(1, 1, At, B1); PG8_BAR; PG8_SCHED;
            PG8_LDB(B0, 1, 0); PG8_LDB(B1, 1, 1); PG8_SCHED; PG8_LDA(At, 1, 0); PG8_STAGE(PG8_SA(0, 1), a2 + hstepA, voffA);
            PG8_WAIT_V(8); PG8_WAIT_L(0); PG8_BAR; PG8_MMA(0, 0, At, B0); PG8_MMA(0, 1, At, B1); PG8_BAR; PG8_SCHED;
            PG8_LDA(At, 1, 1); PG8_STAGE(PG8_SB(1, 0), b3, voffB); PG8_STAGE(PG8_SB(1, 1), b3 + hstepB, voffB); PG8_STAGE(PG8_SA(1, 0), a3, voffA);
            PG8_WAIT_V(8); PG8_WAIT_L(0); PG8_BAR; PG8_MMA(1, 0, At, B0); PG8_MMA(1, 1, At, B1); PG8_BAR; PG8_SCHED;
            } else {
            PG8_LDB(B0, 0, 0); PG8_SCHED; PG8_LDA(At, 0, 0); PG8_STAGE(PG8_SA(1, 1), a1 + hstepA, voffA);
            PG8_WAIT_L(8); PG8_BAR; PG8_WAIT_L(0); PG8_MMA(0, 0, At, B0); PG8_BAR; PG8_SCHED;
            PG8_LDB(B1, 0, 1); PG8_STAGE(PG8_SB(0, 0), b2, voffB);
            PG8_BAR; PG8_WAIT_L(0); PG8_MMA(0, 1, At, B1); PG8_BAR;
            PG8_LDA(At, 0, 1); PG8_STAGE(PG8_SA(0, 0), a2, voffA);
            PG8_BAR; PG8_WAIT_L(0); PG8_MMA(1, 0, At, B0); PG8_BAR; PG8_SCHED;
            PG8_STAGE(PG8_SB(0, 1), b2 + hstepB, voffB);
            PG8_WAIT_V(6); PG8_BAR; PG8_MMA(1, 1, At, B1); PG8_BAR;
            PG8_LDB(B0, 1, 0); PG8_SCHED; PG8_LDA(At, 1, 0); PG8_STAGE(PG8_SA(0, 1), a2 + hstepA, voffA);
            PG8_WAIT_L(8); PG8_BAR; PG8_WAIT_L(0); PG8_MMA(0, 0, At, B0); PG8_BAR; PG8_SCHED;
            PG8_LDB(B1, 1, 1); PG8_STAGE(PG8_SB(1, 0), b3, voffB);
            PG8_BAR; PG8_WAIT_L(0); PG8_MMA(0, 1, At, B1); PG8_BAR;
            PG8_LDA(At, 1, 1); PG8_STAGE(PG8_SA(1, 0), a3, voffA);
            PG8_BAR; PG8_WAIT_L(0); PG8_MMA(1, 0, At, B0); PG8_BAR; PG8_SCHED;
            PG8_STAGE(PG8_SB(1, 1), b3 + hstepB, voffB);
            PG8_WAIT_V(6); PG8_BAR; PG8_MMA(1, 1, At, B1); PG8_BAR;
            }
        }
        t0 = t1; }
        if constexpr (ALIGN_EPI) { if (wr == 0) PG8_BAR; }
        if constexpr (!Epi::AFTER_DRAIN) { E(acc, cur, wr, wc, fr, fq); S.done(cur); }
        if (!has_next) break;
#pragma unroll
        for (int a = 0; a < 2; ++a)
#pragma unroll
            for (int b = 0; b < 2; ++b)
#pragma unroll
                for (int m = 0; m < 4; ++m)
#pragma unroll
                    for (int n = 0; n < 2; ++n) acc[a][b][m][n] = (f32x4){0.f, 0.f, 0.f, 0.f};
        if constexpr (Epi::INIT_ACC) E.init(acc, nxt, wr, wc, fr, fq);
        cur = nxt; cA = nA; cB = nB; ++ui;
        if constexpr (ALIGN_EPI) { if (wr == 1) PG8_BAR; }
    }
    PG8_WAIT_V(0);
    if constexpr (!ALIGN_EPI) { if (wr == 0) PG8_BAR; }
    PG8_BAR;
    if constexpr (Epi::AFTER_DRAIN) { E.fused(acc, cur, wr, wc, fr, fq, lds, wid, lane); S.done(cur); }
#undef PG8_SA
#undef PG8_SB
#undef PG8_STAGE
#undef PG8_LDA
#undef PG8_LDB
#undef PG8_MMA
#undef PG8_WAIT_V
#undef PG8_WAIT_L
#undef PG8_BAR
#undef PG8_SCHED
}
}
#define LAS __attribute__((address_space(3)))
#define RLX_AGENT __ATOMIC_RELAXED, __HIP_MEMORY_SCOPE_AGENT
#define XB_TMO      128
#define XB_XCNT(j)  (256  + 64 * (j))
#define XB_XSUB(j)  (1280 + 64 * (j))
#define XB_XGEN(j)  (2304 + 64 * (j))
#define XB_TOP      3328
#define XB_TOPGEN   3392
#define XCD_BAR_WORDS 3456
#define XB_SPIN_CAP (1u << 18)

__device__ __forceinline__ unsigned xb_ld(unsigned* p)              { return __hip_atomic_load(p, __ATOMIC_RELAXED, __HIP_MEMORY_SCOPE_AGENT); }
__device__ __forceinline__ unsigned xb_add(unsigned* p, unsigned v) { return __hip_atomic_fetch_add(p, v, __ATOMIC_RELAXED, __HIP_MEMORY_SCOPE_AGENT); }
__device__ __forceinline__ unsigned xb_xcc_id() { return (unsigned)__builtin_amdgcn_s_getreg((3 << 11) | 20) & 0xFu; }
#define XB_SPIN(cond, bar) do { unsigned _sp = 0; while (cond) { __builtin_amdgcn_s_sleep(1); \
    if ((++_sp & 255u) == 0u) { if (xb_ld(&(bar)[XB_TMO])) break; if (_sp > XB_SPIN_CAP) { atomicAdd(&(bar)[XB_TMO], 1u); break; } } } } while (0)

struct XcdBarrier {
    unsigned* bar; unsigned x;
    volatile LAS unsigned* st;
};

__device__ __forceinline__ XcdBarrier xcd_barrier_post(unsigned* bar, volatile LAS unsigned* st) {
    XcdBarrier b; b.bar = bar; b.x = xb_xcc_id(); b.st = st;
    if (threadIdx.x == 0) { const unsigned rank = xb_add(&bar[XB_XCNT(b.x)], 1u); st[2] = rank; st[3] = b.x; }
    return b;
}
__device__ __forceinline__ void xcd_barrier_complete(unsigned* bar, unsigned x, unsigned& nloc, unsigned& nx) {
    const unsigned G = gridDim.x * gridDim.y * gridDim.z;
    unsigned sum, cnt, mine, sp = 0u;
    for (;;) {
        sum = 0u; cnt = 0u; mine = 0u;
#pragma unroll
        for (unsigned j = 0; j < 16; ++j) { const unsigned c = xb_ld(&bar[XB_XCNT(j)]); sum += c; cnt += (c > 0u) ? 1u : 0u; mine = (j == x) ? c : mine; }
        if (sum == G) break;
        __builtin_amdgcn_s_sleep(1);
        if ((++sp & 255u) == 0u) { if (xb_ld(&bar[XB_TMO])) break; if (sp > XB_SPIN_CAP) { atomicAdd(&bar[XB_TMO], 1u); break; } }
    }
    nloc = mine > 0u ? mine : 1u; nx = cnt > 0u ? cnt : 1u;
}

__device__ __forceinline__ void xcd_barrier(const XcdBarrier& b) {
    asm volatile("s_waitcnt vmcnt(0)" ::: "memory");
    __syncthreads();
    if (threadIdx.x == 0) {
        unsigned* bar = b.bar;
        __builtin_amdgcn_s_waitcnt(0);
        unsigned nloc = b.st[0], nx = b.st[1];
        if (nloc == 0u) { xcd_barrier_complete(bar, b.x, nloc, nx); b.st[0] = nloc; b.st[1] = nx; }
        const unsigned old = xb_add(&bar[XB_XSUB(b.x)], 1u);
        const unsigned gen = old / nloc;
        if (old + 1u == (gen + 1u) * nloc) {
            __builtin_amdgcn_fence(__ATOMIC_RELEASE, "agent");
            asm volatile("s_waitcnt vmcnt(0)" ::: "memory");
            const unsigned og = xb_add(&bar[XB_TOP], 1u);
            const unsigned tg = og / nx;
            if (og + 1u == (tg + 1u) * nx) xb_add(&bar[XB_TOPGEN], 1u);
            else XB_SPIN(xb_ld(&bar[XB_TOPGEN]) == tg, bar);
            __builtin_amdgcn_fence(__ATOMIC_ACQUIRE, "agent");
            xb_add(&bar[XB_XGEN(b.x)], 1u);
            asm volatile("s_waitcnt vmcnt(0)" ::: "memory");
        } else {
            XB_SPIN(xb_ld(&bar[XB_XGEN(b.x)]) == gen, bar);
            __builtin_amdgcn_fence(__ATOMIC_ACQUIRE, "agent");
            asm volatile("s_waitcnt vmcnt(0)" ::: "memory");
        }
    }
    __syncthreads();
}
#undef LAS

#ifndef GATE2048
#define GATE2048 0
#endif
#define LAS __attribute__((address_space(3)))
typedef unsigned short bf16;
typedef float f32x4 __attribute__((ext_vector_type(4)));
typedef unsigned u32x4 __attribute__((ext_vector_type(4)));
typedef unsigned u32x2 __attribute__((ext_vector_type(2)));
typedef short bf16x8 __attribute__((ext_vector_type(8)));
constexpr int NWAVES = 8, NTHREADS = 512;
constexpr int LDS_BYTES = 147456;
constexpr int MISC_OFF = 131072;
constexpr size_t MiB = 1u << 20;
constexpr size_t WS_CTL = 0, CTL_BYTES = 1 * MiB;
constexpr size_t WS_PS = 1 * MiB, WS_PSV = 2 * MiB;
constexpr size_t WS_XB = 4 * MiB;
constexpr size_t WS_ACT = 36 * MiB;
constexpr size_t A_H = 0;
constexpr size_t A_U = 0, A_V = 32 * MiB, A_T = 64 * MiB, A_GB = 96 * MiB, A_SA = 128 * MiB, A_SB = 160 * MiB;
constexpr size_t WS_W = 228 * MiB;
constexpr size_t E_FIN = (size_t)2 * FF * D, E_FOUT = (size_t)D * FF, E_WIN = (size_t)NIN * D, E_SQ = (size_t)D * D;
constexpr size_t O_F1I = 0, O_F1O = O_F1I + E_FIN, O_WIN = O_F1O + E_FOUT, O_PA = O_WIN + E_WIN, O_PB = O_PA + E_SQ, O_WO = O_PB + E_SQ, O_F2I = O_WO + (GATE2048 ? 2 : 1) * E_SQ, O_F2O = O_F2I + E_FIN, E_LAYER = O_F2O + E_FOUT;
constexpr size_t WS_XL = WS_W + (size_t)DEPTH * E_LAYER * 2;
constexpr size_t WS_END = WS_XL + (size_t)M * D * 2;
static_assert(E_LAYER * 2 == (GATE2048 ? 55 : 53) * MiB, "layer weight bytes");
static_assert((size_t)M * FF * 2 <= 192 * MiB, "H fits");

__device__ __forceinline__ float wave_sum(float v) {
#pragma unroll
    for (int o = 1; o < 64; o <<= 1) v += __shfl_xor(v, o);
    return v;
}
#define LDS_WAIT() asm volatile("s_waitcnt lgkmcnt(0)" ::: "memory")

__device__ __forceinline__ int colmap(int mode, int n) {
    if (mode == 1) { const int pn = n >> 8, half = (n >> 7) & 1, jj = n & 127; return half * FF + pn * 128 + jj; }
    if (mode == 2) { if (n < 3072 || n >= 5120) return n; const int r = n - 3072, q = r >> 8, half = (r >> 7) & 1, jj = r & 127; return 3072 + half * 1024 + q * 128 + jj; }
    return n;
}
__device__ __forceinline__ void transpose_item(const float* W, int K, int Nsrc, int Ndst, int mode, const float* scale, bf16* WT, LAS unsigned* scr, int item, int lane, int ldk = 0) {
    if (ldk == 0) ldk = K;
    const int nblk = Ndst / 64, kb = item / nblk, nb = item % nblk, k0 = 64 * kb, n0 = 64 * nb, s0 = colmap(mode, n0);
    const int r = lane >> 4, c = lane & 15;
    const pg8::rsrc_t rW = pg8::mk_rsrc(W, (size_t)0x7ffffff0), rT = pg8::mk_rsrc(WT, (size_t)0x7ffffff0);
    f32x4 v[8][2];
#pragma unroll
    for (int jj = 0; jj < 8; ++jj) { const unsigned bo = (unsigned)(((size_t)(k0 + 2 * (4 * jj + r)) * Nsrc + s0 + 4 * c) * 4);
        v[jj][0] = __builtin_bit_cast(f32x4, __builtin_amdgcn_raw_buffer_load_b128(rW, bo, 0u, 16)); v[jj][1] = __builtin_bit_cast(f32x4, __builtin_amdgcn_raw_buffer_load_b128(rW, bo, (unsigned)(Nsrc * 4), 16)); }
#pragma unroll
    for (int jj = 0; jj < 8; ++jj) { const int j = 4 * jj + r; float sa = 1.f, sb = 1.f; if (scale) { sa = scale[k0 + 2 * j]; sb = scale[k0 + 2 * j + 1]; }
        u32x4 w; w.x = pg8::cvt_pk_bf16(v[jj][0][0] * sa, v[jj][1][0] * sb); w.y = pg8::cvt_pk_bf16(v[jj][0][1] * sa, v[jj][1][1] * sb); w.z = pg8::cvt_pk_bf16(v[jj][0][2] * sa, v[jj][1][2] * sb); w.w = pg8::cvt_pk_bf16(v[jj][0][3] * sa, v[jj][1][3] * sb);
        *(LAS u32x4*)(scr + j * 68 + 4 * c) = w; }
    LDS_WAIT(); asm volatile("" ::: "memory");
    const int cc = lane & 7;
#pragma unroll
    for (int jj = 0; jj < 8; ++jj) { const int n = (lane >> 3) + 8 * jj; const LAS unsigned* s = scr + (4 * cc) * 68 + n;
        u32x4 o; o.x = s[0]; o.y = s[68]; o.z = s[136]; o.w = s[204];
        pg8::st16_wt(rT, ((size_t)(n0 + n) * ldk + k0 + 8 * cc) * 2, o); }
    LDS_WAIT(); asm volatile("" ::: "memory");
}

struct Args { const float* in[17]; float* out; unsigned char* ws; int ph_lo, ph_hi; };
enum { I_X = 0, I_F1N, I_F1I, I_F1O, I_MN, I_WIN, I_SGN, I_SGW, I_SGB, I_CW, I_PA, I_PB, I_WO, I_F2N, I_F2I, I_F2O, I_FN };

__device__ __forceinline__ void convert_layer(const __attribute__((address_space(4))) Args* ap, LAS unsigned char* lds, int l, int lo, int hi, int widx, int nw, int wave, int lane) {
    LAS unsigned* scr = (LAS unsigned*)(lds + wave * 16384);
    bf16* wl = (bf16*)(ap->ws + WS_W) + (size_t)l * E_LAYER;
    constexpr int IT_FIN = (D / 64) * (2 * FF / 64), IT_FOUT = (FF / 64) * (D / 64), IT_WIN = (D / 64) * (NIN / 64), IT_SQ = (D / 64) * (D / 64);
    for (int g = lo + widx; g < hi; g += nw) {
        int r = g;
        if (r < IT_FIN) { transpose_item(ap->in[I_F1I] + (size_t)l * D * 2 * FF, D, 2 * FF, 2 * FF, 1, ap->in[I_F1N] + l * D, wl + O_F1I, scr, r, lane); continue; } r -= IT_FIN;
        if (r < IT_FOUT) { transpose_item(ap->in[I_F1O] + (size_t)l * FF * D, FF, D, D, 0, nullptr, wl + O_F1O, scr, r, lane); continue; } r -= IT_FOUT;
        if (r < IT_WIN) { transpose_item(ap->in[I_WIN] + (size_t)l * D * NIN, D, NIN, NIN, 2, ap->in[I_MN] + l * D, wl + O_WIN, scr, r, lane); continue; } r -= IT_WIN;
        if (r < IT_SQ) { transpose_item(ap->in[I_PA] + (size_t)l * D * D, D, D, D, 0, nullptr, wl + O_PA, scr, r, lane); continue; } r -= IT_SQ;
        if (r < IT_SQ) { transpose_item(ap->in[I_PB] + (size_t)l * D * D, D, D, D, 0, nullptr, wl + O_PB, scr, r, lane); continue; } r -= IT_SQ;
#if GATE2048
        if (r < IT_SQ) { transpose_item(ap->in[I_WO] + (size_t)l * D * D, D, D, D, 0, nullptr, wl + O_WO, scr, r, lane, 2 * D); continue; } r -= IT_SQ;
        if (r < IT_SQ) { transpose_item(ap->in[I_WO] + (size_t)l * D * D, D, D, D, 0, nullptr, wl + O_WO + D, scr, r, lane, 2 * D); continue; } r -= IT_SQ;
#else
        if (r < IT_SQ) { transpose_item(ap->in[I_WO] + (size_t)l * D * D, D, D, D, 0, nullptr, wl + O_WO, scr, r, lane); continue; } r -= IT_SQ;
#endif
        if (r < IT_FIN) { transpose_item(ap->in[I_F2I] + (size_t)l * D * 2 * FF, D, 2 * FF, 2 * FF, 1, ap->in[I_F2N] + l * D, wl + O_F2I, scr, r, lane); continue; } r -= IT_FIN;
        transpose_item(ap->in[I_F2O] + (size_t)l * FF * D, FF, D, D, 0, nullptr, wl + O_F2O, scr, r, lane);
    }
}
constexpr int IT_LAYER = 2 * ((D / 64) * (2 * FF / 64)) + 2 * ((FF / 64) * (D / 64)) + (D / 64) * (NIN / 64) + (GATE2048 ? 4 : 3) * ((D / 64) * (D / 64));
__device__ __forceinline__ void prologue(const __attribute__((address_space(4))) Args* ap, LAS unsigned char* lds, int gw, int NGW, int wave, int lane) {
    convert_layer(ap, lds, 0, 0, IT_LAYER / 2, gw, NGW, wave, lane);
    const float* x = ap->in[I_X]; bf16* XB = (bf16*)(ap->ws + WS_XB); bf16* XL = (bf16*)(ap->ws + WS_XL); float* PS = (float*)(ap->ws + WS_PS);
    for (int m0 = gw * 4; m0 < M; m0 += NGW * 4) {
        f32x4 v[4][4]; float s[4];
#pragma unroll
        for (int q = 0; q < 4; ++q)
#pragma unroll
            for (int j = 0; j < 4; ++j) v[q][j] = ((const f32x4*)(x + (size_t)(m0 + q) * D) + lane)[64 * j];
#pragma unroll
        for (int q = 0; q < 4; ++q) { float t = 0.f;
#pragma unroll
            for (int j = 0; j < 4; ++j) t += pg8::dot4(v[q][j]);
            s[q] = wave_sum(t); }
        asm volatile("" : "+v"(s[0]), "+v"(s[1]), "+v"(s[2]), "+v"(s[3]) :: "memory");
#pragma unroll
        for (int q = 0; q < 4; ++q) { u32x2* o8 = (u32x2*)(XB + (size_t)(m0 + q) * D) + lane; u32x2* l8 = (u32x2*)(XL + (size_t)(m0 + q) * D) + lane;
#pragma unroll
            for (int j = 0; j < 4; ++j) { u32x2 w; w.x = pg8::cvt_pk_bf16(v[q][j][0], v[q][j][1]); w.y = pg8::cvt_pk_bf16(v[q][j][2], v[q][j][3]); o8[64 * j] = w;
                const f32x4 hf = (f32x4){pg8::bflo(w.x), pg8::bfhi(w.x), pg8::bflo(w.y), pg8::bfhi(w.y)}, d = v[q][j] - hf; u32x2 wl2; wl2.x = pg8::cvt_pk_bf16(d[0], d[1]); wl2.y = pg8::cvt_pk_bf16(d[2], d[3]); if (USE_XL) l8[64 * j] = wl2; }
            if (lane < 16) PS[(size_t)(m0 + q) * 16 + lane] = lane == 0 ? s[q] : 0.f; }
    }
}

struct SguLoads { u32x4 v[4]; f32x4 ps[4]; u32x2 u[4][2]; };
__device__ __forceinline__ void sgu_issue(SguLoads& L, int c, int h, const bf16* U, const bf16* V, const float* PSV, int tid) {
    const int R0 = c * CHUNK, C0 = h * 128, p = tid & 127, dq = tid >> 7;
    const int lane = tid & 63, wid = tid >> 6, wr = wid >> 2, wc = wid & 3, fr = lane & 15, fq = lane >> 4;
#pragma unroll
    for (int i = 0; i < 4; ++i) L.v[i] = *(const u32x4*)(V + (size_t)(R0 + p) * D + C0 + (dq + 4 * i) * 8);
#pragma unroll
    for (int i = 0; i < 4; ++i) L.ps[i] = *(const f32x4*)(PSV + (size_t)(R0 + p) * 16 + 4 * i);
#pragma unroll
    for (int m = 0; m < 4; ++m)
#pragma unroll
        for (int n = 0; n < 2; ++n) L.u[m][n] = *(const u32x2*)(U + (size_t)(R0 + wr * 64 + m * 16 + fr) * D + C0 + wc * 32 + n * 16 + 4 * fq);
}
__device__ __forceinline__ void sgu_phase(LAS unsigned char* lds, int bx, int G, const bf16* U, bf16* UO, const bf16* V, const float* PSV, const float* sgw_l, const float* sgb_l, const float* sgn_l, int tid) {
    LAS bf16* As = (LAS bf16*)lds;
    LAS bf16* Vt = (LAS bf16*)(lds + 34816);
    const int NT = (M / CHUNK) * HEADS;
    if (bx >= NT) return;
    const int h = bx & 7;
    const float* wsh = sgw_l + (size_t)h * CHUNK * CHUNK; const float* bsh = sgb_l + h * CHUNK; const float* gn = sgn_l + h * 128;
    const int lane = tid & 63, wid = tid >> 6, wr = wid >> 2, wc = wid & 3, fr = lane & 15, fq = lane >> 4;
    SguLoads L; sgu_issue(L, bx >> 3, h, U, V, PSV, tid);
#pragma unroll
    for (int i = 0; i < 4; ++i) { const int it = tid + i * NTHREADS, q = it >> 4, p8 = (it & 15) * 8; const float* src = wsh + q * 128 + p8;
        *(LAS u32x4*)(As + q * 136 + p8) = pg8::pack8(*(const f32x4*)src, *(const f32x4*)(src + 4)); }
    f32x4 gv[2]; float bq[4];
#pragma unroll
    for (int n = 0; n < 2; ++n) gv[n] = *(const f32x4*)(gn + wc * 32 + n * 16 + 4 * fq);
#pragma unroll
    for (int m = 0; m < 4; ++m) bq[m] = bsh[wr * 64 + m * 16 + fr];
    for (int t = bx; t < NT; t += G) {
        const int c = t >> 3, R0 = c * CHUNK, C0 = h * 128, p = tid & 127, dq = tid >> 7;
        const float rsp = rsqrtf(((pg8::sum4(L.ps[0]) + pg8::sum4(L.ps[1])) + (pg8::sum4(L.ps[2]) + pg8::sum4(L.ps[3]))) * (1.0f / 1024.0f) + EPS);
#pragma unroll
        for (int i = 0; i < 4; ++i) { f32x4 a, b; pg8::unpack8(L.v[i], a, b); const u32x4 w = pg8::pack8(a * rsp, b * rsp); LAS bf16* dst = Vt + (dq + 4 * i) * 8 * 136 + p;
            dst[0 * 136] = (bf16)(w.x & 0xffffu); dst[1 * 136] = (bf16)(w.x >> 16); dst[2 * 136] = (bf16)(w.y & 0xffffu); dst[3 * 136] = (bf16)(w.y >> 16);
            dst[4 * 136] = (bf16)(w.z & 0xffffu); dst[5 * 136] = (bf16)(w.z >> 16); dst[6 * 136] = (bf16)(w.w & 0xffffu); dst[7 * 136] = (bf16)(w.w >> 16); }
        u32x2 uc[4][2];
#pragma unroll
        for (int m = 0; m < 4; ++m)
#pragma unroll
            for (int n = 0; n < 2; ++n) uc[m][n] = L.u[m][n];
        asm volatile("" : "+v"(uc[0][0]), "+v"(uc[0][1]), "+v"(uc[1][0]), "+v"(uc[1][1]), "+v"(uc[2][0]), "+v"(uc[2][1]), "+v"(uc[3][0]), "+v"(uc[3][1]) :: "memory");
        if (t + G < NT) sgu_issue(L, (t + G) >> 3, h, U, V, PSV, tid);
        __syncthreads();
        f32x4 acc[4][2];
#pragma unroll
        for (int m = 0; m < 4; ++m)
#pragma unroll
            for (int n = 0; n < 2; ++n) acc[m][n] = (f32x4){0.f, 0.f, 0.f, 0.f};
#pragma unroll
        for (int kk = 0; kk < 4; ++kk) { bf16x8 af[4], bf[2];
#pragma unroll
            for (int m = 0; m < 4; ++m) af[m] = *(const LAS bf16x8*)(As + (wr * 64 + m * 16 + fr) * 136 + kk * 32 + fq * 8);
#pragma unroll
            for (int n = 0; n < 2; ++n) bf[n] = *(const LAS bf16x8*)(Vt + (wc * 32 + n * 16 + fr) * 136 + kk * 32 + fq * 8);
#pragma unroll
            for (int m = 0; m < 4; ++m)
#pragma unroll
                for (int n = 0; n < 2; ++n) acc[m][n] = __builtin_amdgcn_mfma_f32_16x16x32_bf16(bf[n], af[m], acc[m][n], 0, 0, 0); }
#pragma unroll
        for (int m = 0; m < 4; ++m)
#pragma unroll
            for (int n = 0; n < 2; ++n) { bf16* uo = UO + (size_t)(R0 + wr * 64 + m * 16 + fr) * D + C0 + wc * 32 + n * 16 + 4 * fq;
                const f32x4 uu = (f32x4){pg8::bflo(uc[m][n].x), pg8::bfhi(uc[m][n].x), pg8::bflo(uc[m][n].y), pg8::bfhi(uc[m][n].y)};
                const f32x4 o = uu * (gv[n] * acc[m][n] + bq[m]);
                u32x2 w; w.x = pg8::cvt_pk_bf16(o[0], o[1]); w.y = pg8::cvt_pk_bf16(o[2], o[3]); *(u32x2*)uo = w; }
        __syncthreads();
    }
}

__device__ __forceinline__ void conv_phase(const bf16* GB, bf16* GBO, const bf16* T, const float* cw, int gtid, int nthr) {
    constexpr int RPS = 16;
    for (int it = gtid; it < (M / RPS) * (D / 8); it += nthr) { const int c8 = (it & 127) * 8, r0 = (it >> 7) * RPS;
        const f32x4 w00 = *(const f32x4*)(cw + c8), w01 = *(const f32x4*)(cw + c8 + 4), w10 = *(const f32x4*)(cw + D + c8), w11 = *(const f32x4*)(cw + D + c8 + 4), w20 = *(const f32x4*)(cw + 2 * D + c8), w21 = *(const f32x4*)(cw + 2 * D + c8 + 4);
#pragma unroll
        for (int hb = 0; hb < 2; ++hb) { const int rb = r0 + 8 * hb; const size_t off = (size_t)rb * D + c8;
            u32x4 t[10], g[8]; const u32x4 z = (u32x4){0u, 0u, 0u, 0u};
            t[0] = ((rb & (SEQ - 1)) > 0) ? *(const u32x4*)(T + off - D) : z;
#pragma unroll
            for (int j = 0; j < 8; ++j) { t[j + 1] = *(const u32x4*)(T + off + (size_t)j * D); g[j] = *(const u32x4*)(GB + off + (size_t)j * D); }
            t[9] = (((rb + 7) & (SEQ - 1)) < SEQ - 1) ? *(const u32x4*)(T + off + (size_t)8 * D) : z;
            u32x4 o[8];
#pragma unroll
            for (int j = 0; j < 8; ++j) { f32x4 a0, a1, b0, b1, c0, c1, g0, g1; pg8::unpack8(t[j], a0, a1); pg8::unpack8(t[j + 1], b0, b1); pg8::unpack8(t[j + 2], c0, c1); pg8::unpack8(g[j], g0, g1);
                o[j] = pg8::pack8(g0 * (w00 * a0 + w10 * b0 + w20 * c0), g1 * (w01 * a1 + w11 * b1 + w21 * c1)); }
            asm volatile("" : "+v"(o[0]), "+v"(o[1]), "+v"(o[2]), "+v"(o[3]), "+v"(o[4]), "+v"(o[5]), "+v"(o[6]), "+v"(o[7]) :: "memory");
#pragma unroll
            for (int j = 0; j < 8; ++j) *(u32x4*)(GBO + off + (size_t)j * D) = o[j];
        } }
}

__device__ __forceinline__ void final_phase(float* out, const bf16* XH, const bf16* XL, const float* g, int gw, int NGW, int lane) {
    f32x4 gv[4];
#pragma unroll
    for (int j = 0; j < 4; ++j) gv[j] = ((const f32x4*)g)[lane + 64 * j];
    for (int m0 = gw * 4; m0 < M; m0 += NGW * 4) { f32x4 v[4][4]; float rs[4];
#pragma unroll
        for (int q = 0; q < 4; ++q)
#pragma unroll
            for (int j = 0; j < 4; ++j) { const u32x2 h = ((const u32x2*)(XH + (size_t)(m0 + q) * D) + lane)[64 * j], lo = USE_XL ? ((const u32x2*)(XL + (size_t)(m0 + q) * D) + lane)[64 * j] : (u32x2){0u, 0u};
                v[q][j] = (f32x4){pg8::bflo(h.x) + pg8::bflo(lo.x), pg8::bfhi(h.x) + pg8::bfhi(lo.x), pg8::bflo(h.y) + pg8::bflo(lo.y), pg8::bfhi(h.y) + pg8::bfhi(lo.y)}; }
#pragma unroll
        for (int q = 0; q < 4; ++q) { float t = 0.f;
#pragma unroll
            for (int j = 0; j < 4; ++j) t += pg8::dot4(v[q][j]);
            rs[q] = rsqrtf(wave_sum(t) * (1.0f / D) + EPS); }
        asm volatile("" : "+v"(rs[0]), "+v"(rs[1]), "+v"(rs[2]), "+v"(rs[3]) :: "memory");
#pragma unroll
        for (int q = 0; q < 4; ++q)
#pragma unroll
            for (int j = 0; j < 4; ++j) ((f32x4*)(out + (size_t)(m0 + q) * D) + lane)[64 * j] = v[q][j] * rs[q] * gv[j]; }
}

__device__ __forceinline__ void final_phase_f32(float* out, const float* g, int gw, int NGW, int lane) {
    f32x4 gv[4];
#pragma unroll
    for (int j = 0; j < 4; ++j) gv[j] = ((const f32x4*)g)[lane + 64 * j];
    for (int m0 = gw * 4; m0 < M; m0 += NGW * 4) { f32x4 v[4][4]; float rs[4];
#pragma unroll
        for (int q = 0; q < 4; ++q)
#pragma unroll
            for (int j = 0; j < 4; ++j) v[q][j] = ((const f32x4*)(out + (size_t)(m0 + q) * D) + lane)[64 * j];
#pragma unroll
        for (int q = 0; q < 4; ++q) { float t = 0.f;
#pragma unroll
            for (int j = 0; j < 4; ++j) t += pg8::dot4(v[q][j]);
            rs[q] = rsqrtf(wave_sum(t) * (1.0f / D) + EPS); }
        asm volatile("" : "+v"(rs[0]), "+v"(rs[1]), "+v"(rs[2]), "+v"(rs[3]) :: "memory");
#pragma unroll
        for (int q = 0; q < 4; ++q)
#pragma unroll
            for (int j = 0; j < 4; ++j) ((f32x4*)(out + (size_t)(m0 + q) * D) + lane)[64 * j] = v[q][j] * rs[q] * gv[j]; }
}

#ifndef RESID_HILO
#define RESID_HILO 1
#endif
#ifndef PROBE_KIND
#define PROBE_KIND -1
#endif
#ifndef PROBE_SKIP_EPI
#define PROBE_SKIP_EPI 0
#endif
#ifndef EN_MASK
#define EN_MASK 63
#endif
#define EN(k) ((EN_MASK >> (k)) & 1)
constexpr int KPL = 9;
constexpr int N_PHASES = 2 + KPL * DEPTH;

constexpr int RS_OFF = MISC_OFF + 1024;
__device__ __forceinline__ void fill_rstd(LAS unsigned char* lds, const float* PS, int pm, int tid) {
    if (tid < 256) { const float* p = PS + (size_t)(pm * 256 + tid) * 16; const f32x4 a = *(const f32x4*)p, b = *(const f32x4*)(p + 4), c = *(const f32x4*)(p + 8), d = *(const f32x4*)(p + 12);
        ((LAS float*)(lds + RS_OFF))[tid] = rsqrtf(((pg8::sum4(a) + pg8::sum4(b)) + (pg8::sum4(c) + pg8::sum4(d))) * (1.0f / 1024.0f) + EPS); }
    __syncthreads();
}
typedef const __attribute__((address_space(4))) Args* KArgs;
__global__ void __launch_bounds__(NTHREADS, 2) fwd(Args a_unused) {
    extern __shared__ __attribute__((aligned(16))) unsigned char lds_raw[];
    LAS unsigned char* lds = (LAS unsigned char*)lds_raw;
    KArgs kap = (KArgs)__builtin_amdgcn_kernarg_segment_ptr();
    const int ph_lo = kap->ph_lo, ph_hi = kap->ph_hi;
#if MK_XCDBAR
    for (int u = threadIdx.x; u < (LDS_BYTES - MISC_OFF) / 4; u += NTHREADS) ((LAS unsigned*)(lds + MISC_OFF))[u] = 0u;
    __syncthreads();
    XcdBarrier bar = xcd_barrier_post((unsigned*)(kap->ws + WS_CTL) + 4096, (volatile LAS unsigned*)(lds + MISC_OFF) + 8);
#endif
    for (int ph = ph_lo; ph < ph_hi; ++ph) {
        if (ph > ph_lo && !(ph >= 1 && ph < N_PHASES - 1 && (ph - 1) % KPL == 5)) {
#if MK_XCDBAR
            if (ph_hi > 1000) cg::this_grid().sync();
            xcd_barrier(bar);
            if (ph == ph_lo + 1) {
                if (threadIdx.x == 0) { bool uni = gridDim.x == 256; for (unsigned j = 0; j < 16; ++j) { const unsigned c = xb_ld(&bar.bar[XB_XCNT(j)]); uni = uni && (c == (j < 8 ? 32u : 0u)); }
                    bar.st[4] = uni ? (bar.st[2] * 8u + bar.st[3]) : blockIdx.x; }
                __syncthreads(); }
#else
            cg::this_grid().sync();
#endif
        }
        int nrep = 1;
#if PROBE_KIND == 100
        if (ph == 0) nrep = 2;
#elif PROBE_KIND >= 0
        if (ph >= 1 && ph < N_PHASES - 1 && ((ph - 1) % KPL) == PROBE_KIND) nrep = 2;
#endif
        for (int rep = 0; rep < nrep; ++rep) {
#if MK_XCDBAR
        if (rep) xcd_barrier(bar);
#else
        if (rep) cg::this_grid().sync();
#endif
        KArgs ap = kap; asm volatile("" : "+s"(ap));
        int tid = threadIdx.x; asm volatile("" : "+v"(tid));
        const int lane = tid & 63, wave = __builtin_amdgcn_readfirstlane(tid >> 6);
        const int G = gridDim.x, bx = (MK_XCDBAR && ph > ph_lo) ? __builtin_amdgcn_readfirstlane((int)((volatile LAS unsigned*)(lds + MISC_OFF))[12]) : (int)blockIdx.x;
        const int gw = bx * NWAVES + wave, NGW = G * NWAVES;
        unsigned char* ws = ap->ws;
        bf16* XB = (bf16*)(ws + WS_XB); float* PS = (float*)(ws + WS_PS); float* PSV = (float*)(ws + WS_PSV);
        unsigned char* act = ws + WS_ACT;
        bf16* Hb = (bf16*)(act + A_H); bf16* Ub = (bf16*)(act + A_U); bf16* Vb = (bf16*)(act + A_V); bf16* Tb = (bf16*)(act + A_T); bf16* GBb = (bf16*)(act + A_GB); bf16* SAb = (bf16*)(act + A_SA); bf16* SBb = (bf16*)(act + A_SB);
        bf16* G2 = (bf16*)(act + A_V);
        bf16* XLb = (bf16*)(ws + WS_XL);
        const bf16* WB = (const bf16*)(ws + WS_W);
        if (EN(5) && ph == 0) { prologue(ap, lds, gw, NGW, wave, lane); continue; }
#if RESID_HILO
        if (ph == N_PHASES - 1) { final_phase(ap->out, XB, XLb, ap->in[I_FN], gw, NGW, lane); continue; }
#else
        if (ph == N_PHASES - 1) { final_phase_f32(ap->out, ap->in[I_FN], gw, NGW, lane); continue; }
#endif
        const int l = (ph - 1) / KPL, kind = (ph - 1) % KPL;
        const bf16* wl = WB + (size_t)l * E_LAYER;
        if (EN(0) && (kind == 0 || kind == 7)) {
            pg8::Gemm g{XB, wl + (kind == 0 ? O_F1I : O_F2I), M, 2 * FF, D}; pg8::StaticOrder S; S.init(M, 2 * FF, G, bx);
            { pg8::Unit u0; S.next(0, u0); fill_rstd(lds, PS, u0.pm, tid); }
            pg8::EpiFfnUp E{Hb, (const LAS float*)(lds + RS_OFF), PROBE_SKIP_EPI && nrep == 2 && rep == 0};
            pg8::gemm_phase<pg8::EpiFfnUp, pg8::StaticOrder, true, true>(lds, g, S, E);
            if (bx >= 128) {
                const int nw = 128 * NWAVES, wi = (bx - 128) * NWAVES + wave;
                if (kind == 0) convert_layer(ap, lds, l, IT_LAYER / 2, IT_LAYER, wi, nw, wave, lane);
                else if (l + 1 < DEPTH) convert_layer(ap, lds, l + 1, 0, IT_LAYER / 2, wi, nw, wave, lane); }
        } else if (EN(1) && (kind == 1 || kind == 8 || kind == 6)) {
            const bool ffn = kind != 6;
            pg8::Gemm g{ffn ? Hb : (GATE2048 ? G2 : SAb), wl + (kind == 1 ? O_F1O : (kind == 8 ? O_F2O : O_WO)), M, D, ffn ? FF : (GATE2048 ? 2 * D : D)}; pg8::StaticOrder S; S.init(M, D, G, bx);
#if RESID_HILO
            pg8::EpiResid E{XB, XLb, PS, ffn ? 0.5f : 1.0f, ffn ? 2.0f : 1.0f};
            pg8::gemm_phase<pg8::EpiResid, pg8::StaticOrder, true, true>(lds, g, S, E);
#else
            pg8::EpiResidF32 E{(l == 0 && kind == 1) ? ap->in[I_X] : ap->out, ap->out, XB, PS, ffn ? 0.5f : 1.0f, ffn ? 2.0f : 1.0f};
            pg8::gemm_phase<pg8::EpiResidF32, pg8::StaticOrder, true, true>(lds, g, S, E);
#endif
        } else if (EN(2) && kind == 2) {
            pg8::Gemm g{XB, wl + O_WIN, M, NIN, D}; pg8::StaticOrder S; S.init(M, NIN, G, bx);
            { pg8::Unit u0; S.next(0, u0); fill_rstd(lds, PS, u0.pm, tid); }
            pg8::EpiMixIn E{Ub, Vb, Tb, GBb, SAb, SBb, (const LAS float*)(lds + RS_OFF), PSV};
            pg8::gemm_phase<pg8::EpiMixIn, pg8::StaticOrder, true, true>(lds, g, S, E);
        } else if (EN(3) && kind == 3) {
            if ((bx >> 3) & 1) {
                conv_phase(GBb, (nrep == 2 && rep == 0) ? (bf16*)(ws + WS_END) : GBb, Tb, ap->in[I_CW] + (size_t)l * 3 * D, bx * NTHREADS + tid, G * NTHREADS);
                sgu_phase(lds, bx, G, Ub, (nrep == 2 && rep == 0) ? (bf16*)(ws + WS_END) : Ub, Vb, PSV, ap->in[I_SGW] + (size_t)l * HEADS * CHUNK * CHUNK, ap->in[I_SGB] + (size_t)l * HEADS * CHUNK, ap->in[I_SGN] + (size_t)l * D, tid);
            } else {
                sgu_phase(lds, bx, G, Ub, (nrep == 2 && rep == 0) ? (bf16*)(ws + WS_END) : Ub, Vb, PSV, ap->in[I_SGW] + (size_t)l * HEADS * CHUNK * CHUNK, ap->in[I_SGB] + (size_t)l * HEADS * CHUNK, ap->in[I_SGN] + (size_t)l * D, tid);
                conv_phase(GBb, (nrep == 2 && rep == 0) ? (bf16*)(ws + WS_END) : GBb, Tb, ap->in[I_CW] + (size_t)l * 3 * D, bx * NTHREADS + tid, G * NTHREADS);
            }
        } else if (EN(4) && kind == 4) {
            pg8::StaticOrder S; S.init(M, D, G, bx);
            pg8::Gemm g{Ub, wl + O_PA, M, D, 2 * D, GBb, wl + O_PB, D / pg8::BK, D, D}; pg8::EpiMerge E{SAb, SBb, SAb};
            pg8::gemm_phase<pg8::EpiMerge, pg8::StaticOrder, true, true>(lds, g, S, E);
        }
        }
    }
}

extern "C" void kernel_launch(void* const* d_in, const int* in_sizes, int n_in, void* d_out, int out_size, void* d_ws, size_t ws_size, hipStream_t stream) {
    static int state = 0;
    if (state == 0) {
        if (n_in != 17 || in_sizes[0] != M * D || out_size != M * D || ws_size < WS_END + (PROBE_KIND == 3 ? 32 * MiB : 0)) { fprintf(stderr, "kernel_launch: unexpected shapes (n_in %d, in0 %d, out %d, ws %zu < %zu)\n", n_in, n_in > 0 ? in_sizes[0] : -1, out_size, ws_size, (size_t)WS_END); state = -1; return; }
        if (hipFuncSetAttribute((const void*)fwd, hipFuncAttributeMaxDynamicSharedMemorySize, LDS_BYTES) != hipSuccess) { fprintf(stderr, "kernel_launch: hipFuncSetAttribute failed\n"); state = -1; return; }
        state = 1;
    }
    if (state < 0) return;
    (void)hipMemsetAsync((char*)d_ws + WS_CTL + 16384, 0, 16384, stream);
    Args a{};
    for (int i = 0; i < 17; ++i) a.in[i] = (const float*)d_in[i];
    a.out = (float*)d_out; a.ws = (unsigned char*)d_ws;
#if MK_SINGLE
    a.ph_lo = 0; a.ph_hi = N_PHASES;
    void* params[] = {&a};
    hipError_t e = hipLaunchCooperativeKernel((const void*)fwd, dim3(256), dim3(NTHREADS), params, LDS_BYTES, stream);
    if (e != hipSuccess) fprintf(stderr, "kernel_launch: cooperative launch failed: %s\n", hipGetErrorString(e));
#else
    for (int ph = 0; ph < N_PHASES; ++ph) { a.ph_lo = ph; a.ph_hi = ph + 1; hipLaunchKernelGGL(fwd, dim3(256), dim3(NTHREADS), LDS_BYTES, stream, a); }
#endif
}
```
